# Optimizing an MI355X kernel written in HIP

```python
import jax
import jax.numpy as jnp
from jax import lax
import numpy as np

D_MODEL = 1024
BATCH = 8
SEQ = 2048
DEPTH = 2

HEAD_DIM = 64
SWA_Q_HEADS = 8
SWA_KV_HEADS = 2
SWA_WINDOW = 128
FOX_HEADS = 4
FOX_Q_BLOCK = 128
MOBA_HEADS = 4
MOBA_BLOCK = 256
MOBA_TOPK = 3
MOBA_Q_CHUNK = 64
ROPE_THETA = 10000.0
RMS_EPS = 1e-5
D_FF = 3584
N_EXPERTS = 8
TOP_K = 2
MOE_BLOCK = 512
N_DENSE = (DEPTH + 1) // 2
N_MOE = DEPTH // 2
NEG_INF = -1e30

SWA_WIDTH = SWA_Q_HEADS * HEAD_DIM
SWA_KV_WIDTH = SWA_KV_HEADS * HEAD_DIM
FOX_WIDTH = FOX_HEADS * HEAD_DIM
MOBA_WIDTH = MOBA_HEADS * HEAD_DIM
MIX_WIDTH = SWA_WIDTH + FOX_WIDTH + MOBA_WIDTH
IN_SPLITS = (SWA_WIDTH, SWA_KV_WIDTH, SWA_KV_WIDTH,
             FOX_WIDTH, FOX_WIDTH, FOX_WIDTH, FOX_HEADS,
             MOBA_WIDTH, MOBA_WIDTH, MOBA_WIDTH)
IN_WIDTH = sum(IN_SPLITS)
SPLIT_POINTS = tuple(int(p) for p in np.cumsum(IN_SPLITS)[:-1])
ATTN_SCALE = HEAD_DIM ** -0.5

kernel_name = 'hymba_style_swa_fox_moba_moe_trunk'


def _rms(x):
    xf = x.astype(jnp.float32)
    return xf * lax.rsqrt(jnp.mean(xf * xf, axis=-1, keepdims=True) + RMS_EPS)


def rmsnorm(x, g):
    return (_rms(x) * g.astype(jnp.float32)).astype(x.dtype)


def rope_tables(seq_len):
    inv = 1.0 / (ROPE_THETA ** (jnp.arange(0, HEAD_DIM, 2, dtype=jnp.float32) / HEAD_DIM))
    ang = jnp.arange(seq_len, dtype=jnp.float32)[:, None] * inv[None, :]
    cos = jnp.concatenate([jnp.cos(ang), jnp.cos(ang)], axis=-1)
    sin = jnp.concatenate([jnp.sin(ang), jnp.sin(ang)], axis=-1)
    return cos, sin


def apply_rope(x, cos, sin):
    xf = x.astype(jnp.float32)
    x1, x2 = jnp.split(xf, 2, axis=-1)
    rot = jnp.concatenate([-x2, x1], axis=-1)
    return (xf * cos[None, :, None, :] + rot * sin[None, :, None, :]).astype(x.dtype)


def swa_sink_attention(q, k, v, sinks):
    B, S, Hq, d = q.shape
    Hkv = k.shape[2]
    G = Hq // Hkv
    W = SWA_WINDOW
    nb = S // W
    qb = q.reshape(B, nb, W, Hkv, G, d)
    pad = ((0, 0), (W, 0), (0, 0), (0, 0))
    kb = jnp.pad(k, pad).reshape(B, nb + 1, W, Hkv, d)
    vb = jnp.pad(v, pad).reshape(B, nb + 1, W, Hkv, d)
    kb2 = jnp.concatenate([kb[:, :-1], kb[:, 1:]], axis=2)
    vb2 = jnp.concatenate([vb[:, :-1], vb[:, 1:]], axis=2)
    s = jnp.einsum('bnqhgd,bnkhd->bnhgqk', qb, kb2).astype(jnp.float32) * ATTN_SCALE
    qi = jnp.arange(W)[:, None]
    kj = jnp.arange(2 * W)[None, :]
    diff = W + qi - kj
    kpos = (jnp.arange(nb)[:, None, None] - 1) * W + kj[None]
    mask = (diff >= 0)[None] & (diff < W)[None] & (kpos >= 0)
    s = jnp.where(mask[None, :, None, None], s, NEG_INF)
    sink = sinks.astype(jnp.float32).reshape(Hkv, G)[None, None, :, :, None, None]
    logits = jnp.concatenate([s, jnp.broadcast_to(sink, s.shape[:-1] + (1,))], axis=-1)
    p = jax.nn.softmax(logits, axis=-1)[..., :-1]
    o = jnp.einsum('bnhgqk,bnkhd->bnqhgd', p.astype(v.dtype), vb2)
    return o.reshape(B, S, Hq * d)


def forgetting_attention(q, k, v, log_f):
    B, S, H, d = q.shape
    Qb = FOX_Q_BLOCK
    nb = S // Qb
    c = jnp.cumsum(log_f, axis=1)
    cT = c.transpose(0, 2, 1)
    kpos = jnp.arange(S)
    qs = q.reshape(B, nb, Qb, H, d).transpose(1, 0, 2, 3, 4)
    cq = c.reshape(B, nb, Qb, H).transpose(1, 0, 3, 2)

    def block(args):
        qx, cx, n = args
        s = jnp.einsum('bqhd,bkhd->bhqk', qx, k).astype(jnp.float32) * ATTN_SCALE
        s = s + cx[..., None] - cT[:, :, None, :]
        qpos = n * Qb + jnp.arange(Qb)
        s = jnp.where(kpos[None, :] <= qpos[:, None], s, NEG_INF)
        p = jax.nn.softmax(s, axis=-1)
        return jnp.einsum('bhqk,bkhd->bqhd', p.astype(v.dtype), v)

    o = lax.map(block, (qs, cq, jnp.arange(nb)))
    return o.transpose(1, 0, 2, 3, 4).reshape(B, S, H * d)


def moba_attention(q, k, v):
    B, S, H, d = q.shape
    Bk = MOBA_BLOCK
    Sp = -(-S // Bk) * Bk
    nkb = Sp // Bk
    pad = ((0, 0), (0, Sp - S), (0, 0), (0, 0))
    qp, kp, vp = jnp.pad(q, pad), jnp.pad(k, pad), jnp.pad(v, pad)
    kb = kp.reshape(B, nkb, Bk, H, d).transpose(0, 3, 1, 2, 4)
    vb = vp.reshape(B, nkb, Bk, H, d).transpose(0, 3, 1, 2, 4)
    kmean = jnp.mean(kb.astype(jnp.float32), axis=3)
    topk = min(MOBA_TOPK, nkb)
    Qc = MOBA_Q_CHUNK
    nqc = Sp // Qc
    qc = qp.reshape(B, nqc, Qc, H, d).transpose(1, 0, 3, 2, 4)
    bi = jnp.arange(B)[:, None, None, None]
    hi = jnp.arange(H)[None, :, None, None]

    def chunk(args):
        qx, n = args
        qpos = n * Qc + jnp.arange(Qc)
        own = (n * Qc) // Bk
        g = jnp.einsum('bhqd,bhnd->bhqn', qx.astype(jnp.float32), kmean)
        g = jnp.where(jnp.arange(nkb) < own, g, NEG_INF)
        _, idx = lax.top_k(g, topk)
        ksel = kb[bi, hi, idx]
        vsel = vb[bi, hi, idx]
        kown = lax.dynamic_index_in_dim(kb, own, axis=2, keepdims=False)
        vown = lax.dynamic_index_in_dim(vb, own, axis=2, keepdims=False)
        s_sel = jnp.einsum('bhqd,bhqtkd->bhqtk', qx, ksel).astype(jnp.float32) * ATTN_SCALE
        valid = (jnp.arange(topk) < own)[:, None]
        s_sel = jnp.where(valid, s_sel, NEG_INF).reshape(B, H, Qc, topk * Bk)
        s_own = jnp.einsum('bhqd,bhkd->bhqk', qx, kown).astype(jnp.float32) * ATTN_SCALE
        kpos = own * Bk + jnp.arange(Bk)
        s_own = jnp.where(kpos[None, :] <= qpos[:, None], s_own, NEG_INF)
        p = jax.nn.softmax(jnp.concatenate([s_sel, s_own], axis=-1), axis=-1).astype(v.dtype)
        p_sel = p[..., :topk * Bk].reshape(B, H, Qc, topk, Bk)
        p_own = p[..., topk * Bk:]
        return (jnp.einsum('bhqtk,bhqtkd->bhqd', p_sel, vsel)
                + jnp.einsum('bhqk,bhkd->bhqd', p_own, vown))

    o = lax.map(chunk, (qc, jnp.arange(nqc)))
    o = o.transpose(1, 0, 3, 2, 4).reshape(B, Sp, H * d)
    return o[:, :S]


def hybrid_mixer(h, norm_g, w_in, forget_bias, sinks, mix_gain, w_out, cos, sin):
    B, S, _ = h.shape
    u = rmsnorm(h, norm_g) @ w_in
    aq, ak, av, bq, bk, bv, bf, cq, ck, cv = jnp.split(u, SPLIT_POINTS, axis=-1)
    heads = lambda t, n: t.reshape(B, S, n, HEAD_DIM)
    oa = swa_sink_attention(apply_rope(heads(aq, SWA_Q_HEADS), cos, sin),
                            apply_rope(heads(ak, SWA_KV_HEADS), cos, sin),
                            heads(av, SWA_KV_HEADS), sinks)
    log_f = jax.nn.log_sigmoid(bf.astype(jnp.float32) + forget_bias.astype(jnp.float32))
    ob = forgetting_attention(heads(bq, FOX_HEADS), heads(bk, FOX_HEADS),
                              heads(bv, FOX_HEADS), log_f)
    oc = moba_attention(apply_rope(heads(cq, MOBA_HEADS), cos, sin),
                        apply_rope(heads(ck, MOBA_HEADS), cos, sin),
                        heads(cv, MOBA_HEADS))
    y = jnp.concatenate([_rms(oa), _rms(ob), _rms(oc)], axis=-1) * mix_gain.astype(jnp.float32)
    return y.astype(h.dtype) @ w_out


def swiglu(x, w_gate, w_up, w_down):
    return (jax.nn.silu(x @ w_gate) * (x @ w_up)) @ w_down


def moe_swiglu(x, w_router, w_gate, w_up, w_down):
    B, S, D = x.shape
    T = B * S
    xt = x.reshape(T, D)
    logits = (xt @ w_router).astype(jnp.float32)
    top_v, top_i = lax.top_k(logits, TOP_K)
    gates = jax.nn.softmax(top_v, axis=-1)
    e_flat = top_i.reshape(-1)
    tok_flat = jnp.repeat(jnp.arange(T), TOP_K)
    g_flat = gates.reshape(-1)
    order = jnp.argsort(e_flat)
    e_s, tok_s, g_s = e_flat[order], tok_flat[order], g_flat[order]
    counts = jax.ops.segment_sum(jnp.ones_like(e_flat), e_flat, num_segments=N_EXPERTS)
    starts = jnp.cumsum(counts) - counts
    padded = (counts + MOE_BLOCK - 1) // MOE_BLOCK * MOE_BLOCK
    pends = jnp.cumsum(padded)
    pstarts = pends - padded
    dest = pstarts[e_s] + (jnp.arange(T * TOP_K) - starts[e_s])
    P = -(-(T * TOP_K) // MOE_BLOCK) * MOE_BLOCK + N_EXPERTS * MOE_BLOCK
    nblk = P // MOE_BLOCK
    xbuf = jnp.zeros((P, D), x.dtype).at[dest].set(xt[tok_s])
    blk_start = jnp.arange(nblk) * MOE_BLOCK
    blk_expert = jnp.minimum(jnp.sum(blk_start[:, None] >= pends[None, :], axis=1), N_EXPERTS - 1)

    def run(args):
        xb, e = args
        return swiglu(xb, w_gate[e], w_up[e], w_down[e])

    ybuf = lax.map(run, (xbuf.reshape(nblk, MOE_BLOCK, D), blk_expert)).reshape(P, D)
    y = jnp.zeros((T, D), x.dtype).at[tok_s].add(ybuf[dest] * g_s[:, None].astype(x.dtype))
    return y.reshape(B, S, D)


def setup_inputs(seed: int = 0) -> dict:
    key = jax.random.key(seed)
    ks = jax.random.split(key, 17)
    nrm = lambda k, shape, scale: jax.random.normal(k, shape, jnp.float32) * scale
    return {
        'x': nrm(ks[0], (BATCH, SEQ, D_MODEL), 1.0),
        'attn_norm': 1.0 + nrm(ks[1], (DEPTH, D_MODEL), 0.02),
        'w_in': nrm(ks[2], (DEPTH, D_MODEL, IN_WIDTH), D_MODEL ** -0.5),
        'fox_forget_bias': 2.0 + nrm(ks[3], (DEPTH, FOX_HEADS), 0.5),
        'swa_sinks': nrm(ks[4], (DEPTH, SWA_Q_HEADS), 0.5),
        'mix_gain': 1.0 + nrm(ks[5], (DEPTH, MIX_WIDTH), 0.02),
        'w_out': nrm(ks[6], (DEPTH, MIX_WIDTH, D_MODEL), MIX_WIDTH ** -0.5),
        'ffn_norm': 1.0 + nrm(ks[7], (DEPTH, D_MODEL), 0.02),
        'dense_w_gate': nrm(ks[8], (N_DENSE, D_MODEL, D_FF), D_MODEL ** -0.5),
        'dense_w_up': nrm(ks[9], (N_DENSE, D_MODEL, D_FF), D_MODEL ** -0.5),
        'dense_w_down': nrm(ks[10], (N_DENSE, D_FF, D_MODEL), D_FF ** -0.5),
        'router_w': nrm(ks[11], (N_MOE, D_MODEL, N_EXPERTS), D_MODEL ** -0.5),
        'moe_w_gate': nrm(ks[12], (N_MOE, N_EXPERTS, D_MODEL, D_FF), D_MODEL ** -0.5),
        'moe_w_up': nrm(ks[13], (N_MOE, N_EXPERTS, D_MODEL, D_FF), D_MODEL ** -0.5),
        'moe_w_down': nrm(ks[14], (N_MOE, N_EXPERTS, D_FF, D_MODEL), D_FF ** -0.5),
        'final_norm': 1.0 + nrm(ks[15], (D_MODEL,), 0.02),
    }


def reference(x, attn_norm, w_in, fox_forget_bias, swa_sinks, mix_gain, w_out, ffn_norm,
              dense_w_gate, dense_w_up, dense_w_down, router_w, moe_w_gate, moe_w_up,
              moe_w_down, final_norm):
    cos, sin = rope_tables(x.shape[1])
    h = x
    for layer in range(DEPTH):
        h = h + hybrid_mixer(h, attn_norm[layer], w_in[layer], fox_forget_bias[layer],
                             swa_sinks[layer], mix_gain[layer], w_out[layer], cos, sin)
        z = rmsnorm(h, ffn_norm[layer])
        j = layer // 2
        if layer % 2 == 0:
            h = h + swiglu(z, dense_w_gate[j], dense_w_up[j], dense_w_down[j])
        else:
            h = h + moe_swiglu(z, router_w[j], moe_w_gate[j], moe_w_up[j], moe_w_down[j])
    return rmsnorm(h, final_norm)
```

```cpp
#include <hip/hip_runtime.h>
#include <hip/hip_cooperative_groups.h>
#include <cstdint>
#include <cstdio>
namespace cg = cooperative_groups;

#ifndef USE_FAST_ATTN
#define USE_FAST_ATTN 1
#endif
#ifndef USE_FAST_GEMM
#define USE_FAST_GEMM 1
#endif
#ifndef MK_MULTI
#define MK_MULTI 0
#endif

#define LAS __attribute__((address_space(3)))
typedef unsigned short bf16_t;
typedef short bf16x8 __attribute__((ext_vector_type(8)));
typedef float f32x4 __attribute__((ext_vector_type(4)));
typedef float f32x2 __attribute__((ext_vector_type(2)));
typedef unsigned u32x4 __attribute__((ext_vector_type(4)));
typedef unsigned u32x2 __attribute__((ext_vector_type(2)));
typedef __bf16 bf16x2_t __attribute__((ext_vector_type(2)));

constexpr int T_TOK = 16384, DM = 1024, SEQ = 2048, NBATCH = 8, FF = 3584, NE = 8;
constexpr int NIN = 2560;
constexpr int W_IN_LD = 2308;
constexpr float RMS_EPS = 1e-5f;
constexpr float LOG2E = 1.4426950408889634f;
constexpr float QSCALE = 0.125f * LOG2E;
constexpr int NWAVES = 8, NTHREADS = 512;

constexpr size_t MiB = 1u << 20;
constexpr size_t OFF_CTL = 0;
constexpr size_t CTL_BYTES = 32768;
constexpr size_t OFF_ROPE = 1 * MiB;
constexpr size_t OFF_SSQA = 2 * MiB;
constexpr size_t OFF_SSQB = 3 * MiB;
constexpr size_t OFF_LOGF = 4 * MiB;
constexpr size_t OFF_CW = 4 * MiB + 256 * 1024;
constexpr size_t OFF_CT = 4 * MiB + 512 * 1024;
constexpr size_t OFF_KMEAN = 4 * MiB + 768 * 1024;
constexpr size_t OFF_TOKE = 5 * MiB;
constexpr size_t OFF_TOKP = 5 * MiB + 128 * 1024;
constexpr size_t OFF_TOKG = 5 * MiB + 256 * 1024;
constexpr size_t OFF_IDX = 6 * MiB;
constexpr size_t OFF_WRT = 6 * MiB + 512 * 1024;
constexpr size_t OFF_PLOG = 244 * MiB;
constexpr size_t OFF_RSE = 7 * MiB;
constexpr size_t OFF_MGU = 8 * MiB;
constexpr size_t OFF_MDN = 120 * MiB;
constexpr size_t OFF_HB = 176 * MiB;
constexpr size_t OFF_WIN = 208 * MiB;
constexpr size_t OFF_WOUT = 218 * MiB;
constexpr size_t OFF_DGU = 222 * MiB;
constexpr size_t OFF_DDN = 236 * MiB;
constexpr size_t OFF_Q = 244 * MiB;
constexpr size_t OFF_K = 276 * MiB;
constexpr size_t OFF_VT = 296 * MiB;
constexpr size_t OFF_Y = 316 * MiB;
constexpr size_t OFF_DACT = 244 * MiB;
constexpr size_t OFF_MACT = 208 * MiB;
constexpr size_t OFF_YBUF = 8 * MiB;
constexpr size_t WS_NEED = 448 * MiB;

constexpr int LDS_BYTES = 163840;

struct Params {
    const float* in[16];
    float* out;
    unsigned char* ws;
    int ph_lo, ph_hi;
};

__device__ __forceinline__ unsigned pk2(float lo, float hi) { f32x2 v = {lo, hi}; bf16x2_t b = __builtin_convertvector(v, bf16x2_t); return __builtin_bit_cast(unsigned, b); }
__device__ __forceinline__ unsigned short f2bf(float f) { return (unsigned short)(pk2(f, 0.f) & 0xffffu); }
__device__ __forceinline__ float bf2f(unsigned short b) { return __uint_as_float(((unsigned)b) << 16); }
__device__ __forceinline__ float bflo(unsigned w) { return __uint_as_float(w << 16); }
__device__ __forceinline__ float bfhi(unsigned w) { return __uint_as_float(w & 0xffff0000u); }
__device__ __forceinline__ float dpp_f(float v, const int ctrl_sel) {
    const int x = __builtin_bit_cast(int, v);
    int r;
    if (ctrl_sel == 0) r = __builtin_amdgcn_mov_dpp(x, 0xB1, 0xf, 0xf, true);
    else if (ctrl_sel == 1) r = __builtin_amdgcn_mov_dpp(x, 0x4E, 0xf, 0xf, true);
    else if (ctrl_sel == 2) r = __builtin_amdgcn_mov_dpp(x, 0x141, 0xf, 0xf, true);
    else r = __builtin_amdgcn_mov_dpp(x, 0x140, 0xf, 0xf, true);
    return __builtin_bit_cast(float, r);
}
__device__ __forceinline__ float wave_sum(float v) {
    v += dpp_f(v, 0); v += dpp_f(v, 1); v += dpp_f(v, 2); v += dpp_f(v, 3);
    { auto r = __builtin_amdgcn_permlane16_swap(__float_as_uint(v), __float_as_uint(v), false, false); v = __uint_as_float(r[0]) + __uint_as_float(r[1]); }
    { auto r = __builtin_amdgcn_permlane32_swap(__float_as_uint(v), __float_as_uint(v), false, false); v = __uint_as_float(r[0]) + __uint_as_float(r[1]); }
    return v;
}
__device__ __forceinline__ int phys32(int r) { return 16 * ((r >> 2) & 1) + 4 * (r >> 3) + (r & 3); }

__device__ __forceinline__ void tr_item(const float* __restrict__ W, int ld, int K, int nblk, const float* __restrict__ gs, bf16_t* __restrict__ Wt,
                                        int mapkind, int bj, int srcshift1536, LAS float* scr, int item, int lane) {
    const int kb = item / nblk, nb = item % nblk, k0 = 64 * kb, c0 = 32 * nb;
    const int srcc0 = (srcshift1536 && c0 >= 1536) ? c0 + 4 : c0;
    float vv[32];
#pragma unroll
    for (int i = 0; i < 32; ++i) vv[i] = W[(size_t)(k0 + 2 * i + (lane >> 5)) * ld + srcc0 + (lane & 31)];
    if (gs) {
#pragma unroll
        for (int i = 0; i < 32; ++i) vv[i] *= gs[k0 + 2 * i + (lane >> 5)];
    }
#pragma unroll
    for (int i = 0; i < 32; ++i) scr[(2 * i + (lane >> 5)) * 33 + (lane & 31)] = vv[i];
    asm volatile("s_waitcnt lgkmcnt(0)" ::: "memory");
    const int c = lane & 7;
#pragma unroll
    for (int j = 0; j < 4; ++j) {
        const int n = (lane >> 3) + 8 * j;
        int P;
        if (mapkind == 0) P = (c0 & ~32) | (n & 15) | ((n & 16) << 1) | ((c0 & 32) >> 1);
        else if (mapkind == 1) P = c0 + phys32(n);
        else P = (c0 >> 7) * 256 + 128 * bj + (c0 & 96) + phys32(n);
        const LAS float* s = scr + (8 * c) * 33 + n;
        u32x4 o; o.x = pk2(s[0 * 33], s[1 * 33]); o.y = pk2(s[2 * 33], s[3 * 33]); o.z = pk2(s[4 * 33], s[5 * 33]); o.w = pk2(s[6 * 33], s[7 * 33]);
        *(u32x4*)(Wt + (size_t)P * K + k0 + 8 * c) = o;
    }
    asm volatile("s_waitcnt lgkmcnt(0)" ::: "memory");
}

constexpr int I_IN = 16 * 72, I_OUT = 16 * 32, I_GU = 16 * 112, I_DN = 56 * 32;
constexpr int NITEMS_EARLY = 2 * I_IN + 2 * I_OUT + 2 * I_GU + I_DN;
constexpr int NITEMS_MOE = 8 * I_DN + 16 * I_GU;
__device__ __forceinline__ void conv_item(const Params& p, LAS float* scr, int it, int lane) {
    unsigned char* ws = p.ws;
    int r = it;
    if (r < 2 * I_IN) { const int l = r / I_IN; r %= I_IN;
        tr_item(p.in[2] + (size_t)l * DM * W_IN_LD, W_IN_LD, DM, 72, p.in[1] + l * DM, (bf16_t*)(ws + OFF_WIN) + (size_t)l * NIN * DM, 0, 0, 1, scr, r, lane); return; }
    r -= 2 * I_IN;
    if (r < 2 * I_OUT) { const int l = r / I_OUT; r %= I_OUT;
        tr_item(p.in[6] + (size_t)l * DM * DM, DM, DM, 32, p.in[5] + l * DM, (bf16_t*)(ws + OFF_WOUT) + (size_t)l * DM * DM, 1, 0, 0, scr, r, lane); return; }
    r -= 2 * I_OUT;
    if (r < 2 * I_GU) { const int bj = r / I_GU; r %= I_GU;
        tr_item(bj ? p.in[9] : p.in[8], FF, DM, 112, p.in[7], (bf16_t*)(ws + OFF_DGU), 2, bj, 0, scr, r, lane); return; }
    r -= 2 * I_GU;
    if (r < I_DN) { tr_item(p.in[10], DM, FF, 32, nullptr, (bf16_t*)(ws + OFF_DDN), 1, 0, 0, scr, r, lane); return; }
    r -= I_DN;
    if (r < 8 * I_DN) { const int e = r / I_DN; r %= I_DN;
        tr_item(p.in[14] + (size_t)e * FF * DM, DM, FF, 32, nullptr, (bf16_t*)(ws + OFF_MDN) + (size_t)e * DM * FF, 1, 0, 0, scr, r, lane); return; }
    r -= 8 * I_DN;
    { const int e = r / (2 * I_GU); r %= 2 * I_GU; const int bj = r / I_GU; r %= I_GU;
        tr_item((bj ? p.in[13] : p.in[12]) + (size_t)e * DM * FF, FF, DM, 112, p.in[7] + DM, (bf16_t*)(ws + OFF_MGU) + (size_t)e * 2 * FF * DM, 2, bj, 0, scr, r, lane); }
}
__device__ __forceinline__ void conv_range(const Params& p, LAS unsigned char* lds, int lo, int hi) {
    const int tid = threadIdx.x, lane = tid & 63, wave = tid >> 6;
    const int gw = blockIdx.x * NWAVES + wave, NGW = gridDim.x * NWAVES;
    LAS float* scr = (LAS float*)(lds + wave * 8704);
    for (int it = lo + gw; it < hi; it += NGW) conv_item(p, scr, it, lane);
}
__device__ __forceinline__ void phase_prologue(const Params& p, LAS unsigned char* lds) {
    const int tid = threadIdx.x, lane = tid & 63, wave = tid >> 6;
    const int gw = blockIdx.x * NWAVES + wave, NGW = gridDim.x * NWAVES;
    unsigned char* ws = p.ws;
    conv_range(p, lds, 0, NITEMS_EARLY);
    {
        const int gt = blockIdx.x * NTHREADS + tid, NG = gridDim.x * NTHREADS;
        for (int it = gt; it < 2 * 256 * 128; it += NG) {
            const int m = it / (256 * 128), rr = (it / 128) % 256, k0 = (it % 128) * 8;
            float v[8];
#pragma unroll
            for (int q = 0; q < 8; ++q) v[q] = 0.f;
            if (rr < 4) {
#pragma unroll
                for (int q = 0; q < 8; ++q) v[q] = p.in[2][(size_t)m * DM * W_IN_LD + (size_t)(k0 + q) * W_IN_LD + 1536 + rr] * p.in[1][m * DM + k0 + q]; }
            u32x4 o; o.x = pk2(v[0], v[1]); o.y = pk2(v[2], v[3]); o.z = pk2(v[4], v[5]); o.w = pk2(v[6], v[7]);
            *(u32x4*)((bf16_t*)(ws + OFF_WIN) + ((size_t)m * NIN + 2304 + rr) * DM + k0) = o;
        }
        float* wrf = (float*)(ws + OFF_WRT);
        for (int it = gt; it < 8 * DM; it += NG) { const int e = it >> 10, k = it & 1023; wrf[it] = p.in[11][(size_t)k * 8 + e] * p.in[7][DM + k]; }
    }
    {
        const float* x = p.in[0]; bf16_t* hb = (bf16_t*)(ws + OFF_HB); float* ssq = (float*)(ws + OFF_SSQA);
        for (int row = gw; row < T_TOK; row += NGW) {
            const f32x4* xr = (const f32x4*)(x + (size_t)row * DM) + lane;
            f32x4 v[4]; float s = 0.f;
#pragma unroll
            for (int j = 0; j < 4; ++j) { v[j] = xr[64 * j]; s += (v[j].x * v[j].x + v[j].y * v[j].y) + (v[j].z * v[j].z + v[j].w * v[j].w); }
            s = wave_sum(s);
            u32x2* o8 = (u32x2*)(hb + (size_t)row * DM) + lane;
#pragma unroll
            for (int j = 0; j < 4; ++j) { u32x2 w; w.x = pk2(v[j].x, v[j].y); w.y = pk2(v[j].z, v[j].w); o8[64 * j] = w; }
            if (lane < 16) ssq[(size_t)row * 16 + lane] = (lane == 0) ? s : 0.f;
        }
    }
    {
        float* cs = (float*)(ws + OFF_ROPE); float* sn = cs + SEQ * 32;
        for (int i = blockIdx.x * NTHREADS + tid; i < SEQ * 32; i += gridDim.x * NTHREADS) {
            const int t = i >> 5, f = i & 31;
            double inv = 1.0;
            for (int k = 0; k < f; ++k) inv *= 0.74989420933245582730;
            const float invf = (float)inv;
            const float angf = (float)t * invf;
            const double xa = (double)angf;
            const double n = __builtin_rint(xa * 0.63661977236758134308);
            const double rr = (xa - n * 1.5707963267948966192) - n * 6.123233995736766e-17;
            const double r2 = rr * rr;
            double sp = rr * (1.0 + r2 * (-1.0 / 6 + r2 * (1.0 / 120 + r2 * (-1.0 / 5040 + r2 * (1.0 / 362880 + r2 * (-1.0 / 39916800 + r2 * (1.0 / 6227020800.0)))))));
            double cp = 1.0 + r2 * (-0.5 + r2 * (1.0 / 24 + r2 * (-1.0 / 720 + r2 * (1.0 / 40320 + r2 * (-1.0 / 3628800 + r2 * (1.0 / 479001600.0 + r2 * (-1.0 / 87178291200.0)))))));
            const int q = ((int)n) & 3;
            double c, s;
            if (q == 0) { c = cp; s = sp; } else if (q == 1) { c = -sp; s = cp; } else if (q == 2) { c = -cp; s = -sp; } else { c = sp; s = -cp; }
            cs[i] = (float)c; sn[i] = (float)s;
        }
    }
}

struct Unit { int orow0, rows, brow0, pn; const int* gidx; int koff; const float* rsp; int tile, trow0; };

struct DenseSched {
    int nM, nN, nwg, G, c, full, rem, mode;
    __device__ void init(int M, int Nphys, int G_, int c_, int mode_ = 0) { nM = M / 256; nN = Nphys / 256; nwg = nM * nN; G = G_; c = c_; full = nwg / G; rem = nwg % G; mode = mode_;
        if (mode && !(rem > 0 && 2 * rem <= G)) mode = mode_ == 1 ? 0 : 3; }
    __device__ void tile(int L, int& pm, int& pn) const {
        int wgid = L; { const int q = nwg / 8, r = nwg % 8, xcd = wgid % 8, off = wgid / 8; wgid = (xcd < r ? xcd * (q + 1) : r * (q + 1) + (xcd - r) * q) + off; }
        const int nig = 8 * nN, gid = wgid / nig, fm = gid * 8, gsz = (nM - fm) < 8 ? (nM - fm) : 8;
        pm = fm + ((wgid % nig) % gsz); pn = (wgid % nig) / gsz;
    }
    __device__ bool next(int i, Unit& u) const {
        int pm, pn, half = -1;
        if (mode == 3) return false;
        if (mode == 2) { if (i > 0 || c >= 2 * rem) return false; tile(full * G + (c >> 1), pm, pn); half = c & 1; }
        else { const long L = (long)i * G + c; if (L >= (mode == 1 ? (long)full * G : (long)nwg)) return false; tile((int)L, pm, pn); }
        u.orow0 = pm * 256 + (half > 0 ? 128 : 0); u.rows = half >= 0 ? 128 : 256; u.brow0 = pn * 256; u.pn = pn; u.gidx = nullptr; u.koff = 0; u.rsp = nullptr; u.tile = 0; u.trow0 = u.orow0; return true;
    }
};
struct MoeSched {
    int cnt[NE], base[NE], nrt[NE], total, nct, nphys, G, c, ksplit, khalf, mode, full, rem; const int* idx; const float* rse;
    bool gather;
    bool quad;
    __device__ void init(const int* counts, const int* idx_, int nct_, int nphys_, int G_, int c_, bool gather_, int ksplit_ = 1, int khalf_ = 0, int mode_ = 0, bool quad_ = false) {
        gather = gather_; ksplit = ksplit_; khalf = khalf_; rse = nullptr; quad = quad_;
        int b = 0, tot = 0;
#pragma unroll
        for (int e = 0; e < NE; ++e) { cnt[e] = counts[e]; base[e] = b; b += cnt[e]; nrt[e] = (cnt[e] + 255) >> 8; tot += nrt[e] * nct_ * ksplit_; }
        total = tot; nct = nct_; nphys = nphys_; G = G_; c = c_; idx = idx_;
        full = total / G; rem = total % G; mode = mode_;
        if (mode && !(rem > 0 && (quad ? 4 : 2) * rem <= G)) mode = mode_ == 1 ? 0 : 3;
    }
    __device__ bool next(int i, Unit& u) const {
        int half = -1, kq = 0; long L;
        if (mode == 3) return false;
        if (mode == 2 && quad) { if (i > 0 || c >= 4 * rem) return false; L = (long)full * G + (c >> 2); half = c & 1; kq = (c >> 1) & 1; }
        else if (mode == 2) { if (i > 0 || c >= 2 * rem) return false; L = (long)full * G + (c >> 1); half = c & 1; }
        else { L = (long)i * G + c; if (L >= (mode == 1 ? (long)full * G : (long)total)) return false; }
        int l = (int)L, e = 0;
#pragma unroll
        for (int k = 0; k < NE; ++k) { const int n = nrt[k] * nct * ksplit; if (e == k && l >= n) { l -= n; e = k + 1; } }
        int nr = 1, bs = 0, cn = 0;
#pragma unroll
        for (int k = 0; k < NE; ++k) if (e == k) { nr = nrt[k]; bs = base[k]; cn = cnt[k]; }
        int kh = l % ksplit; l /= ksplit;
        if (quad) kh = kq;
        const int ctile = l / nr, rt = l % nr;
        int rows = min(256, cn - rt * 256), roff = 0;
        if (half >= 0) { if (half == 1 && rows > 128) { roff = 128; rows -= 128; } else rows = min(rows, 128); }
        u.orow0 = bs + rt * 256 + roff; u.rows = rows; u.brow0 = e * nphys + ctile * 256; u.pn = ctile + (kh << 8); u.koff = kh * khalf;
        u.gidx = gather ? idx + (size_t)e * T_TOK + rt * 256 + roff : nullptr; u.rsp = rse + (size_t)e * T_TOK + rt * 256 + roff;
        u.tile = (int)(L - (long)full * G); u.trow0 = bs + rt * 256; return true;
    }
};

__device__ __forceinline__ float rstd_from_ssq(const float* ssq, int tok) {
    const f32x4* q = (const f32x4*)(ssq + (size_t)tok * 16);
    const f32x4 a = q[0], b = q[1], c = q[2], d = q[3];
    const float s = ((a.x + a.y) + (a.z + a.w)) + ((b.x + b.y) + (b.z + b.w)) + ((c.x + c.y) + (c.z + c.w)) + ((d.x + d.y) + (d.z + d.w));
    return __builtin_amdgcn_rsqf(s * (1.0f / DM) + RMS_EPS);
}

struct EpiInProj {
    const float* ssq; const float* cosT; const float* sinT; bf16_t* Q; bf16_t* Kb; bf16_t* Vt; float* flog; const float* fbias;
    __device__ __forceinline__ void operator()(const f32x4 (&acc)[2][2][4][2], const Unit& u, int wr, int wc, int fr, int fq) const {
        const int hh = wc >> 1, g = wc & 1;
        int kind[2], col0[2];
#pragma unroll
        for (int bj = 0; bj < 2; ++bj) { const int hp = u.pn * 2 + bj; int k, c;
            if (hp < 4) { k = 0; c = hp * 128; } else if (hp == 4) { k = 1; c = 0; } else if (hp == 5) { k = 4; c = 0; }
            else if (hp < 8) { k = 2; c = 512 + (hp - 6) * 128; } else if (hp < 10) { k = 3; c = 128 + (hp - 8) * 128; } else if (hp < 12) { k = 4; c = 2 + (hp - 10) * 2; }
            else if (hp < 14) { k = 0; c = 768 + (hp - 12) * 128; } else if (hp < 16) { k = 1; c = 384 + (hp - 14) * 128; } else if (hp < 18) { k = 4; c = 6 + (hp - 16) * 2; }
            else if (hp == 18) { k = 5; c = 0; } else { k = 6; c = 0; }
            kind[bj] = k; col0[bj] = c; }
        const bool need_rope = kind[0] <= 1 || kind[1] <= 1;
#pragma unroll
        for (int ai = 0; ai < 2; ++ai) {
            if (128 * ai >= u.rows) continue;
#pragma unroll
            for (int m = 0; m < 4; ++m) {
                const int row = u.orow0 + 128 * ai + 64 * wr + 16 * m + fr;
                const float rs = rstd_from_ssq(ssq, row);
                const int t = row & (SEQ - 1), b = row >> 11;
                f32x4 cs = {0.f, 0.f, 0.f, 0.f}, sn = {0.f, 0.f, 0.f, 0.f};
                if (need_rope) { cs = *(const f32x4*)(cosT + t * 32 + 16 * g + 4 * fq); sn = *(const f32x4*)(sinT + t * 32 + 16 * g + 4 * fq); }
#pragma unroll
                for (int bj = 0; bj < 2; ++bj) {
                    const int kd = kind[bj];
                    if (kd == 6) continue;
                    if (kd == 5) { if (wc == 0 && fq == 0) { const f32x4 fb = *(const f32x4*)fbias; *(f32x4*)(flog + (size_t)row * 4) = acc[ai][bj][m][0] * rs + fb; } continue; }
                    const float sc = (kd == 0 || kd == 2) ? rs * QSCALE : rs;
                    f32x4 x1 = acc[ai][bj][m][0] * sc, x2 = acc[ai][bj][m][1] * sc;
                    if (kd <= 1) { const f32x4 o1 = x1 * cs - x2 * sn, o2 = x2 * cs + x1 * sn; x1 = o1; x2 = o2; }
                    if (kd == 4) {
                        const int tp = (t & ~15) | (((t >> 2) & 1) << 3) | (((t >> 3) & 1) << 2) | (t & 3);
                        const unsigned odd = fr & 1;
                        bf16_t* vb = Vt + ((size_t)(b * 10 + col0[bj] + hh) * 64 + 16 * g + 4 * fq + odd) * SEQ + (tp & ~1);
#pragma unroll
                        for (int hx = 0; hx < 2; ++hx) {
                            const f32x4 xx = hx ? x2 : x1;
                            const unsigned wa = pk2(xx[0], xx[1]), wb = pk2(xx[2], xx[3]);
                            const unsigned pa = (unsigned)__builtin_amdgcn_mov_dpp((int)wa, 0xB1, 0xf, 0xf, true), pb = (unsigned)__builtin_amdgcn_mov_dpp((int)wb, 0xB1, 0xf, 0xf, true);
                            const unsigned oa = odd ? ((pa >> 16) | (wa & 0xffff0000u)) : ((wa & 0xffffu) | (pa << 16)), ob = odd ? ((pb >> 16) | (wb & 0xffff0000u)) : ((wb & 0xffffu) | (pb << 16));
                            *(unsigned*)(vb + (size_t)(32 * hx) * SEQ) = oa; *(unsigned*)(vb + (size_t)(32 * hx + 2) * SEQ) = ob;
                        }
                    } else {
                        const unsigned w1x = pk2(x1[0], x1[1]), w1y = pk2(x1[2], x1[3]), w2x = pk2(x2[0], x2[1]), w2y = pk2(x2[2], x2[3]);
                        const auto sx = __builtin_amdgcn_permlane16_swap(w1x, w2x, false, false), sy = __builtin_amdgcn_permlane16_swap(w1y, w2y, false, false);
                        bf16_t* dst = ((kd == 0 || kd == 2) ? Q + (size_t)row * 1024 : Kb + (size_t)row * 640) + col0[bj] + hh * 64 + 16 * g + 4 * (fq & 2) + 32 * (fq & 1);
                        *(u32x4*)dst = (u32x4){sx[0], sy[0], sx[1], sy[1]};
                    }
                }
            }
        }
    }
};
template <bool ROUTER> struct EpiResid {
    bf16_t* hb; float* ssq; const float* wrf; float* plog;
    __device__ __forceinline__ void operator()(const f32x4 (&acc)[2][2][4][2], const Unit& u, int wr, int wc, int fr, int fq) const {
#pragma unroll
        for (int ai = 0; ai < 2; ++ai) {
            u32x4 pre[ROUTER ? 1 : 4][2];
            if (!ROUTER) {
#pragma unroll
                for (int m = 0; m < 4; ++m)
#pragma unroll
                    for (int bj = 0; bj < 2; ++bj) pre[ROUTER ? 0 : m][bj] = *(const u32x4*)(hb + (size_t)(u.orow0 + 128 * ai + 64 * wr + 16 * m + fr) * DM + u.pn * 256 + 128 * bj + 32 * wc + 8 * fq);
                asm volatile("" ::: "memory");
            }
#pragma unroll
            for (int m = 0; m < 4; ++m) {
                const int row = u.orow0 + 128 * ai + 64 * wr + 16 * m + fr;
                float ss = 0.f;
                f32x4 vv[2][2];
#pragma unroll
                for (int bj = 0; bj < 2; ++bj) {
                    const size_t off = (size_t)row * DM + u.pn * 256 + 128 * bj + 32 * wc + 8 * fq;
                    const u32x4 rw = ROUTER ? *(const u32x4*)(hb + off) : pre[ROUTER ? 0 : m][bj];
                    const f32x4 r0 = {bflo(rw.x), bfhi(rw.x), bflo(rw.y), bfhi(rw.y)}, r1 = {bflo(rw.z), bfhi(rw.z), bflo(rw.w), bfhi(rw.w)};
                    const f32x4 v0 = r0 + acc[ai][bj][m][0], v1 = r1 + acc[ai][bj][m][1];
                    u32x4 w; w.x = pk2(v0[0], v0[1]); w.y = pk2(v0[2], v0[3]); w.z = pk2(v1[0], v1[1]); w.w = pk2(v1[2], v1[3]);
                    *(u32x4*)(hb + off) = w;
                    ss += (v0[0] * v0[0] + v0[1] * v0[1]) + (v0[2] * v0[2] + v0[3] * v0[3]) + (v1[0] * v1[0] + v1[1] * v1[1]) + (v1[2] * v1[2] + v1[3] * v1[3]);
                    vv[bj][0] = v0; vv[bj][1] = v1;
                }
                ss += __shfl_xor(ss, 16); ss += __shfl_xor(ss, 32);
                if (fq == 0) ssq[(size_t)row * 16 + u.pn * 4 + wc] = ss;
                if (ROUTER) {
                    float pl[8];
#pragma unroll
                    for (int e = 0; e < 8; ++e) { float a = 0.f;
#pragma unroll
                        for (int bj = 0; bj < 2; ++bj) { const f32x4* wp = (const f32x4*)(wrf + e * DM + u.pn * 256 + 128 * bj + 32 * wc + 8 * fq); const f32x4 w0 = wp[0], w1 = wp[1];
                            a += (vv[bj][0][0] * w0[0] + vv[bj][0][1] * w0[1]) + (vv[bj][0][2] * w0[2] + vv[bj][0][3] * w0[3]) + (vv[bj][1][0] * w1[0] + vv[bj][1][1] * w1[1]) + (vv[bj][1][2] * w1[2] + vv[bj][1][3] * w1[3]); }
                        a += __shfl_xor(a, 16); a += __shfl_xor(a, 32); pl[e] = a; }
                    if (fq == 0) { f32x4* dp = (f32x4*)(plog + ((size_t)row * 16 + u.pn * 4 + wc) * 8); dp[0] = (f32x4){pl[0], pl[1], pl[2], pl[3]}; dp[1] = (f32x4){pl[4], pl[5], pl[6], pl[7]}; }
                }
            }
        }
    }
};
template <bool MOE> struct EpiSwiGLU {
    const float* ssq; bf16_t* act;
    __device__ __forceinline__ void operator()(const f32x4 (&acc)[2][2][4][2], const Unit& u, int wr, int wc, int fr, int fq) const {
        float rs[2][4];
#pragma unroll
        for (int ai = 0; ai < 2; ++ai)
#pragma unroll
            for (int m = 0; m < 4; ++m) {
                const int r = 128 * ai + 64 * wr + 16 * m + fr; const int rr = r < u.rows ? r : u.rows - 1;
                if (MOE) rs[ai][m] = u.rsp[rr]; else rs[ai][m] = rstd_from_ssq(ssq, u.orow0 + rr);
            }
#pragma unroll
        for (int ai = 0; ai < 2; ++ai) {
            float g[4][8], e[4][8];
#pragma unroll
            for (int m = 0; m < 4; ++m)
#pragma unroll
                for (int q = 0; q < 8; ++q) { g[m][q] = acc[ai][0][m][q >> 2][q & 3] * rs[ai][m]; e[m][q] = __builtin_amdgcn_exp2f(g[m][q] * (-LOG2E)); }
#pragma unroll
            for (int m = 0; m < 4; ++m)
#pragma unroll
                for (int q = 0; q < 8; ++q) e[m][q] = __builtin_amdgcn_rcpf(1.0f + e[m][q]);
#pragma unroll
            for (int m = 0; m < 4; ++m) {
                const int r = 128 * ai + 64 * wr + 16 * m + fr;
                float o[8];
#pragma unroll
                for (int q = 0; q < 8; ++q) o[q] = (g[m][q] * e[m][q]) * (acc[ai][1][m][q >> 2][q & 3] * rs[ai][m]);
                if (r < u.rows) { u32x4 w; w.x = pk2(o[0], o[1]); w.y = pk2(o[2], o[3]); w.z = pk2(o[4], o[5]); w.w = pk2(o[6], o[7]);
                    *(u32x4*)(act + (size_t)(u.orow0 + r) * FF + u.pn * 128 + 32 * wc + 8 * fq) = w; }
            }
        }
    }
};
struct EpiY {
    unsigned char* ws;
    static constexpr size_t OFF_SIDE = 72 * MiB;
    __device__ __forceinline__ static bf16_t* yrow(unsigned char* ws_, int row) { return (bf16_t*)(ws_ + OFF_YBUF) + (size_t)row * DM; }
    __device__ __forceinline__ void operator()(const f32x4 (&acc)[2][2][4][2], const Unit& u, int wr, int wc, int fr, int fq) const {
        const int kh = u.pn >> 8, pn = u.pn & 255;
#pragma unroll
        for (int ai = 0; ai < 2; ++ai)
#pragma unroll
            for (int m = 0; m < 4; ++m) {
                const int r = 128 * ai + 64 * wr + 16 * m + fr;
                if (r < u.rows) {
                    bf16_t* yr = kh ? (bf16_t*)(ws + OFF_SIDE) + ((size_t)u.tile * 256 + (u.orow0 + r - u.trow0)) * 256 : yrow(ws, u.orow0 + r) + pn * 256;
#pragma unroll
                    for (int bj = 0; bj < 2; ++bj) { const f32x4 v0 = acc[ai][bj][m][0], v1 = acc[ai][bj][m][1];
                        u32x4 w; w.x = pk2(v0[0], v0[1]); w.y = pk2(v0[2], v0[3]); w.z = pk2(v1[0], v1[1]); w.w = pk2(v1[2], v1[3]);
                        *(u32x4*)(yr + 128 * bj + 32 * wc + 8 * fq) = w; }
                }
            }
    }
};

template <class Epi, class Sched>
__device__ __forceinline__ void gemm_simple(const bf16_t* __restrict__ A, const bf16_t* __restrict__ Bt, int K, int Kloop, const Sched& S, const Epi& E) {
    const int tid = threadIdx.x, wid = tid >> 6, lane = tid & 63, wr = wid >> 2, wc = wid & 3, fr = lane & 15, fq = lane >> 4;
    Unit u;
    for (int i = 0; S.next(i, u); ++i) {
        f32x4 acc[2][2][4][2];
#pragma unroll
        for (int a = 0; a < 2; ++a)
#pragma unroll
            for (int b = 0; b < 2; ++b)
#pragma unroll
                for (int m = 0; m < 4; ++m)
#pragma unroll
                    for (int n = 0; n < 2; ++n) acc[a][b][m][n] = (f32x4){0.f, 0.f, 0.f, 0.f};
        const bf16_t* ar[2][4]; const bf16_t* br[2][2];
#pragma unroll
        for (int ai = 0; ai < 2; ++ai)
#pragma unroll
            for (int m = 0; m < 4; ++m) { int r = 128 * ai + 64 * wr + 16 * m + fr; if (r >= u.rows) r = u.rows - 1;
                const int src = u.gidx ? u.gidx[r] : u.orow0 + r; ar[ai][m] = A + (size_t)src * K + u.koff + 8 * fq; }
#pragma unroll
        for (int bj = 0; bj < 2; ++bj)
#pragma unroll
            for (int n = 0; n < 2; ++n) br[bj][n] = Bt + (size_t)(u.brow0 + 128 * bj + 32 * wc + 16 * n + fr) * K + u.koff + 8 * fq;
        for (int k0 = 0; k0 < Kloop; k0 += 32) {
            bf16x8 a[2][4], b[2][2];
#pragma unroll
            for (int ai = 0; ai < 2; ++ai)
#pragma unroll
                for (int m = 0; m < 4; ++m) a[ai][m] = *(const bf16x8*)(ar[ai][m] + k0);
#pragma unroll
            for (int bj = 0; bj < 2; ++bj)
#pragma unroll
                for (int n = 0; n < 2; ++n) b[bj][n] = *(const bf16x8*)(br[bj][n] + k0);
#pragma unroll
            for (int ai = 0; ai < 2; ++ai)
#pragma unroll
                for (int bj = 0; bj < 2; ++bj)
#pragma unroll
                    for (int m = 0; m < 4; ++m)
#pragma unroll
                        for (int n = 0; n < 2; ++n) acc[ai][bj][m][n] = __builtin_amdgcn_mfma_f32_16x16x32_bf16(b[bj][n], a[ai][m], acc[ai][bj][m][n], 0, 0, 0);
        }
        E(acc, u, wr, wc, fr, fq);
    }
}

namespace pg {
constexpr int BK = 64, HALF = 128, HTB = HALF * BK * 2, STAGE_BYTES = 8 * HTB;
__device__ __forceinline__ int lds_byte(int r, int c) { const int st = (r >> 4) * 2 + (c >> 5), rr = r & 15, cc = c & 31, ob = rr * 64 + cc * 2; return st * 1024 + (ob ^ (((ob >> 9) & 1) << 5)); }
__device__ __forceinline__ void stage_rc(int b, int& R, int& C) { const int st = b / 1024, sb = b % 1024, swz = sb ^ (((sb >> 9) & 1) << 5); R = (st >> 1) * 16 + swz / 64; C = (st & 1) * 32 + (swz % 64) / 2; }

template <bool HALFROWS, class Epi, class Sched>
__device__ __forceinline__ void gemm_fast(LAS unsigned char* lds, const bf16_t* A, const bf16_t* Bt, const int K, const int Kloop, const Sched& S, const Epi& E) {
    const int tid = threadIdx.x, wid = __builtin_amdgcn_readfirstlane(tid >> 6), lane = tid & 63, wr = wid >> 2, wc = wid & 3, fr = lane & 15, fq = lane >> 4;
    const int nt = Kloop / BK;
    int Rv[2], Cv[2];
    unsigned voffB[2];
#pragma unroll
    for (int i = 0; i < 2; ++i) { stage_rc(tid * 16 + i * 8192, Rv[i], Cv[i]); voffB[i] = (unsigned)(Rv[i] * K + Cv[i]) * 2u; }
    const size_t kstep = (size_t)(BK * 2);
    const size_t hstepB = (size_t)HALF * K * 2;
    const unsigned ldsw = (unsigned)wid * 1024u;
    const int aoff = lds_byte(wr * 64 + fr, fq * 8), boff = lds_byte(wc * 32 + fr, fq * 8);
#define PG_SA(b, h) (((b) * 2 + (h)) * HTB)
#define PG_SB(b, h) ((4 + (b) * 2 + (h)) * HTB)
#define PG_STAGE(bufoff, gbase, voff) do { _Pragma("unroll") for (int _i = 0; _i < 2; ++_i) \
        __builtin_amdgcn_global_load_lds((const unsigned*)((const char*)(gbase) + (voff)[_i]), (LAS unsigned*)(lds + (bufoff) + ldsw + _i * 8192), 16, 0, 0); } while (0)
#define PG_LDA(dst, b, h) do { _Pragma("unroll") for (int m = 0; m < 4; ++m) _Pragma("unroll") for (int k = 0; k < 2; ++k) dst[m][k] = *(const LAS bf16x8*)(lds + PG_SA(b, h) + aoff + m * 2048 + k * 1024); } while (0)
#define PG_LDB(dst, b, h) do { _Pragma("unroll") for (int n = 0; n < 2; ++n) _Pragma("unroll") for (int k = 0; k < 2; ++k) dst[n][k] = *(const LAS bf16x8*)(lds + PG_SB(b, h) + boff + n * 2048 + k * 1024); } while (0)
#define PG_MMA(ai, bj, At, Bf) do { __builtin_amdgcn_s_setprio(1); _Pragma("unroll") for (int m = 0; m < 4; ++m) _Pragma("unroll") for (int n = 0; n < 2; ++n) _Pragma("unroll") for (int k = 0; k < 2; ++k) \
        acc[ai][bj][m][n] = __builtin_amdgcn_mfma_f32_16x16x32_bf16(Bf[n][k], At[m][k], acc[ai][bj][m][n], 0, 0, 0); __builtin_amdgcn_s_setprio(0); } while (0)
#define PG_WAIT_V(n) asm volatile("s_waitcnt vmcnt(" #n ")" ::: "memory")
#define PG_WAIT_L(n) asm volatile("s_waitcnt lgkmcnt(" #n ")" ::: "memory")
#define PG_BAR __builtin_amdgcn_s_barrier()
#define PG_SCHED __builtin_amdgcn_sched_barrier(0)
#define PG_ALOAD(u, sr) do { _Pragma("unroll") for (int _i = 0; _i < 2; ++_i) { \
        int r0_ = Rv[_i], r1_ = 128 + Rv[_i]; if (r0_ >= (u).rows) r0_ = (u).rows - 1; if (r1_ >= (u).rows) r1_ = (u).rows - 1; \
        sr[2 * _i] = (u).gidx ? (u).gidx[r0_] : (u).orow0 + r0_; sr[2 * _i + 1] = (u).gidx ? (u).gidx[r1_] : (u).orow0 + r1_; } } while (0)
#define PG_AFIN(sr, a0, a1) do { _Pragma("unroll") for (int _i = 0; _i < 2; ++_i) { \
        a0[_i] = ((unsigned)sr[2 * _i] * (unsigned)K + (unsigned)Cv[_i]) * 2u; a1[_i] = ((unsigned)sr[2 * _i + 1] * (unsigned)K + (unsigned)Cv[_i]) * 2u; } } while (0)
    Unit cur, nxt, nn; int ui = 0;
    if (!S.next(0, cur)) return;
    f32x4 acc[2][2][4][2];
#pragma unroll
    for (int a = 0; a < 2; ++a)
#pragma unroll
        for (int b = 0; b < 2; ++b)
#pragma unroll
            for (int m = 0; m < 4; ++m)
#pragma unroll
                for (int n = 0; n < 2; ++n) acc[a][b][m][n] = (f32x4){0.f, 0.f, 0.f, 0.f};
    bf16x8 At[4][2], B0[2][2], B1[2][2];
    unsigned ca0[2], ca1[2], na0[2], na1[2];
    int sr[4];
    bool has_next = S.next(1, nxt);
    if (!has_next) nxt = cur;
    PG_ALOAD(cur, sr); PG_AFIN(sr, ca0, ca1);
    PG_ALOAD(nxt, sr); PG_AFIN(sr, na0, na1);
    const char* Ab = (const char*)A + (size_t)cur.koff * 2;
    const char* cB = (const char*)Bt + (size_t)cur.brow0 * K * 2 + (size_t)cur.koff * 2;
    PG_STAGE(PG_SB(0, 0), cB, voffB); PG_STAGE(PG_SB(0, 1), cB + hstepB, voffB); PG_STAGE(PG_SA(0, 0), Ab, ca0); PG_STAGE(PG_SA(0, 1), Ab, ca1);
    if (wr == 1) PG_BAR;
    PG_WAIT_V(2); PG_BAR;
    PG_STAGE(PG_SB(1, 0), cB + kstep, voffB); PG_STAGE(PG_SA(1, 0), Ab + kstep, ca0); PG_STAGE(PG_SB(1, 1), cB + hstepB + kstep, voffB);
    PG_WAIT_V(6); PG_BAR;
    for (;;) {
        bool has_nn = has_next && S.next(ui + 2, nn);
        if (!has_nn) nn = nxt;
        const char* nB = (const char*)Bt + (size_t)nxt.brow0 * K * 2 + (size_t)nxt.koff * 2;
        const char* nAb = (const char*)A + (size_t)nxt.koff * 2;
        for (int t = 0; t < nt; t += 2) {
            const bool last = (t == nt - 2);
            const char* a1p = Ab + (size_t)(t + 1) * kstep;
            const char* a2p = last ? nAb : Ab + (size_t)(t + 2) * kstep; const char* b2p = last ? nB : cB + (size_t)(t + 2) * kstep;
            const char* a3p = a2p + kstep; const char* b3p = b2p + kstep;
            unsigned s0[2], s1[2];
#pragma unroll
            for (int i = 0; i < 2; ++i) { s0[i] = last ? na0[i] : ca0[i]; s1[i] = last ? na1[i] : ca1[i]; }
            PG_LDB(B0, 0, 0); PG_LDB(B1, 0, 1); PG_SCHED; PG_LDA(At, 0, 0); PG_STAGE(PG_SA(1, 1), a1p, ca1);
            PG_WAIT_V(8); PG_WAIT_L(0); PG_BAR; PG_MMA(0, 0, At, B0); PG_MMA(0, 1, At, B1); PG_BAR; PG_SCHED;
            PG_LDA(At, 0, 1); PG_STAGE(PG_SB(0, 0), b2p, voffB); PG_STAGE(PG_SB(0, 1), b2p + hstepB, voffB); PG_STAGE(PG_SA(0, 0), a2p, s0);
            PG_WAIT_V(8); PG_WAIT_L(0); PG_BAR; if constexpr (!HALFROWS) { PG_MMA(1, 0, At, B0); PG_MMA(1, 1, At, B1); } PG_BAR; PG_SCHED;
            PG_LDB(B0, 1, 0); PG_LDB(B1, 1, 1); PG_SCHED; PG_LDA(At, 1, 0); PG_STAGE(PG_SA(0, 1), a2p, s1);
            PG_WAIT_V(8); PG_WAIT_L(0); PG_BAR; PG_MMA(0, 0, At, B0); PG_MMA(0, 1, At, B1); PG_BAR; PG_SCHED;
            PG_LDA(At, 1, 1); PG_STAGE(PG_SB(1, 0), b3p, voffB); PG_STAGE(PG_SB(1, 1), b3p + hstepB, voffB); PG_STAGE(PG_SA(1, 0), a3p, s0);
            PG_WAIT_V(8); PG_WAIT_L(0); PG_BAR; if constexpr (!HALFROWS) { PG_MMA(1, 0, At, B0); PG_MMA(1, 1, At, B1); } PG_BAR; PG_SCHED;
        }
        if (wr == 0) PG_BAR;
        PG_ALOAD(nn, sr);
        E(acc, cur, wr, wc, fr, fq);
        if (!has_next) break;
#pragma unroll
        for (int a = 0; a < 2; ++a)
#pragma unroll
            for (int b = 0; b < 2; ++b)
#pragma unroll
                for (int m = 0; m < 4; ++m)
#pragma unroll
                    for (int n = 0; n < 2; ++n) acc[a][b][m][n] = (f32x4){0.f, 0.f, 0.f, 0.f};
        cur = nxt; cB = nB; Ab = nAb; ++ui;
#pragma unroll
        for (int i = 0; i < 2; ++i) { ca0[i] = na0[i]; ca1[i] = na1[i]; }
        nxt = nn; has_next = has_nn;
        PG_AFIN(sr, na0, na1);
        if (wr == 1) PG_BAR;
    }
    PG_WAIT_V(0);
    PG_BAR;
#undef PG_SA
#undef PG_SB
#undef PG_STAGE
#undef PG_LDA
#undef PG_LDB
#undef PG_MMA
#undef PG_WAIT_V
#undef PG_WAIT_L
#undef PG_BAR
#undef PG_SCHED
#undef PG_ALOAD
#undef PG_AFIN
}
}

__device__ __forceinline__ void phase_kmean(const Params& p, LAS unsigned char* lds) {
    const int tid = threadIdx.x;
    const bf16_t* Kb = (const bf16_t*)(p.ws + OFF_K); float* km = (float*)(p.ws + OFF_KMEAN);
    LAS float* red = (LAS float*)lds;
    for (int unit = blockIdx.x; unit < NBATCH * 4 * 8; unit += gridDim.x) {
        const int b = unit >> 5, hm = (unit >> 3) & 3, blk = unit & 7;
        const int ch = tid & 7, rg = tid >> 3;
        const bf16_t* src = Kb + (size_t)(b * SEQ + blk * 256 + rg * 4) * 640 + 384 + hm * 64 + ch * 8;
        u32x4 w[4];
#pragma unroll
        for (int i = 0; i < 4; ++i) w[i] = *(const u32x4*)(src + (size_t)i * 640);
        float sacc[8];
#pragma unroll
        for (int q = 0; q < 8; ++q) sacc[q] = 0.f;
#pragma unroll
        for (int i = 0; i < 4; ++i) { sacc[0] += bflo(w[i].x); sacc[1] += bfhi(w[i].x); sacc[2] += bflo(w[i].y); sacc[3] += bfhi(w[i].y);
            sacc[4] += bflo(w[i].z); sacc[5] += bfhi(w[i].z); sacc[6] += bflo(w[i].w); sacc[7] += bfhi(w[i].w); }
        LAS f32x4* rp = (LAS f32x4*)(red + rg * 64 + ch * 8);
        rp[0] = (f32x4){sacc[0], sacc[1], sacc[2], sacc[3]}; rp[1] = (f32x4){sacc[4], sacc[5], sacc[6], sacc[7]};
        __syncthreads();
        if (tid < 64) { float t = 0.f;
#pragma unroll 8
            for (int q = 0; q < 64; ++q) t += red[q * 64 + tid];
            km[(size_t)unit * 64 + tid] = t * (1.0f / 256.0f); }
        __syncthreads();
    }
}

__device__ __forceinline__ void phase_scan(const Params& p, LAS unsigned char* lds) {
    const int tid = threadIdx.x, lane = tid & 63, wave = tid >> 6;
    const float* flog = (const float*)(p.ws + OFF_LOGF); float* cw = (float*)(p.ws + OFF_CW);
    LAS float* wtot = (LAS float*)(lds + 4096);
    for (int unit = blockIdx.x; unit < NBATCH * 4; unit += gridDim.x) {
        const int b = unit >> 2, h = unit & 3;
        float v[4]; float run = 0.f;
#pragma unroll
        for (int q = 0; q < 4; ++q) { const float xv = flog[(size_t)(b * SEQ + 4 * tid + q) * 4 + h];
            const float ls = fminf(xv, 0.f) - 0.6931471805599453f * __builtin_amdgcn_logf(1.0f + __builtin_amdgcn_exp2f(-fabsf(xv) * LOG2E));
            run += ls; v[q] = run; }
        float inc = run;
#pragma unroll
        for (int o = 1; o < 64; o <<= 1) { const float t = __shfl_up(inc, o); if (lane >= o) inc += t; }
        if (lane == 63) wtot[wave] = inc;
        __syncthreads();
        float woff = 0.f;
#pragma unroll
        for (int w = 0; w < 8; ++w) { const float t = wtot[w]; if (w < wave) woff += t; }
        const float base = woff + (inc - run);
        f32x4 o; o.x = (base + v[0]) * LOG2E; o.y = (base + v[1]) * LOG2E; o.z = (base + v[2]) * LOG2E; o.w = (base + v[3]) * LOG2E;
        *(f32x4*)(cw + (size_t)unit * SEQ + 4 * tid) = o;
        __syncthreads();
    }
}

template <int KIND>
__device__ __forceinline__ void naive_attn_token(const Params& p, int layer, int row, int lane) {
    const bf16_t* Q = (const bf16_t*)(p.ws + OFF_Q); const bf16_t* Kb = (const bf16_t*)(p.ws + OFF_K); const bf16_t* Vt = (const bf16_t*)(p.ws + OFF_VT);
    bf16_t* Y = (bf16_t*)(p.ws + OFF_Y);
    const int b = row >> 11, t = row & (SEQ - 1);
    constexpr int NH = KIND == 0 ? 8 : 4;
    constexpr int QC0 = KIND == 0 ? 0 : (KIND == 1 ? 512 : 768);
    constexpr int KC0 = KIND == 0 ? 0 : (KIND == 1 ? 128 : 384);
    constexpr int VH0 = KIND == 0 ? 0 : (KIND == 1 ? 2 : 6);
    float sstot = 0.f;
    const int own = t >> 8;
    for (int h = 0; h < NH; ++h) {
        const int kvh = KIND == 0 ? (h >> 2) : h;
        const float qv = bf2f(Q[(size_t)row * 1024 + QC0 + h * 64 + lane]);
        unsigned selmask = 0;
        if (KIND == 2) {
            const float* km = (const float*)(p.ws + OFF_KMEAN) + (size_t)(b * 4 + h) * 8 * 64;
            float gsc[8];
#pragma unroll
            for (int j = 0; j < 8; ++j) gsc[j] = wave_sum(qv * km[j * 64 + lane]);
            const int nsel = own < 3 ? own : 3;
            for (int r = 0; r < nsel; ++r) { float best = -3.0e38f; int bi = 0;
#pragma unroll
                for (int j = 0; j < 8; ++j) { const bool ok = (j < own) && !((selmask >> j) & 1u); if (ok && gsc[j] > best) { best = gsc[j]; bi = j; } }
                selmask |= 1u << bi; }
        }
        float ctq = 0.f;
        const float* cwp = (const float*)(p.ws + OFF_CW) + (size_t)(b * 4 + h) * SEQ;
        if (KIND == 1) ctq = cwp[t];
        float mx = -1e30f, l = 0.f, oacc = 0.f;
        const int lo = KIND == 0 ? (t - 127 > 0 ? t - 127 : 0) : 0;
        const bf16_t* kbase = Kb + (size_t)(b * SEQ) * 640 + KC0 + kvh * 64;
        const bf16_t* vbase = Vt + (size_t)(b * 10 + VH0 + kvh) * 64 * SEQ;
        for (int s0 = lo & ~63; s0 <= t; s0 += 64) {
            if (KIND == 2) { const int blk = s0 >> 8; if (blk != own && !((selmask >> blk) & 1u)) continue; }
            const int s = s0 + lane;
            const u32x4* kp = (const u32x4*)(kbase + (size_t)s * 640);
            float a = 0.f;
#pragma unroll
            for (int c = 0; c < 8; ++c) { const u32x4 w = kp[c];
                a += __shfl(qv, 8 * c + 0) * bflo(w.x) + __shfl(qv, 8 * c + 1) * bfhi(w.x) + __shfl(qv, 8 * c + 2) * bflo(w.y) + __shfl(qv, 8 * c + 3) * bfhi(w.y)
                   + __shfl(qv, 8 * c + 4) * bflo(w.z) + __shfl(qv, 8 * c + 5) * bfhi(w.z) + __shfl(qv, 8 * c + 6) * bflo(w.w) + __shfl(qv, 8 * c + 7) * bfhi(w.w); }
            if (KIND == 1) a += ctq - cwp[s];
            const bool ok = (s <= t) && (s >= lo);
            float cm = ok ? a : -1e30f;
#pragma unroll
            for (int o = 1; o < 64; o <<= 1) cm = fmaxf(cm, __shfl_xor(cm, o));
            const float mnew = fmaxf(mx, cm);
            const float alpha = exp2f(mx - mnew);
            const float pj = ok ? exp2f(a - mnew) : 0.f;
            l = l * alpha + wave_sum(pj); mx = mnew;
            oacc *= alpha;
            const unsigned short pb = f2bf(pj);
            const float pjr = bf2f(pb);
            for (int d = 0; d < 64; ++d) { const float v = bf2f(vbase[(size_t)d * SEQ + s]); const float x = wave_sum(pjr * v); if (lane == d) oacc += x; }
        }
        if (KIND == 0) { const float sk = p.in[4][layer * 8 + h] * LOG2E; l += exp2f(sk - mx); }
        const float ov = oacc / l;
        sstot += wave_sum(ov * ov);
        Y[(size_t)row * 1024 + QC0 + h * 64 + lane] = f2bf(ov);
    }
    const float scale = 1.0f / sqrtf(sstot / (float)(NH * 64) + RMS_EPS);
    for (int h = 0; h < NH; ++h) { bf16_t* yp = Y + (size_t)row * 1024 + QC0 + h * 64 + lane; *yp = f2bf(bf2f(*yp) * scale); }
}
__device__ __forceinline__ void phase_attn_naive(const Params& p, int layer) {
    const int tid = threadIdx.x, lane = tid & 63, wave = tid >> 6;
    const int gw = blockIdx.x * NWAVES + wave, NGW = gridDim.x * NWAVES;
    for (int it = gw; it < 3 * T_TOK; it += NGW) {
        const int kind = it / T_TOK, row = it % T_TOK;
        if (kind == 0) naive_attn_token<0>(p, layer, row, lane); else if (kind == 1) naive_attn_token<1>(p, layer, row, lane); else naive_attn_token<2>(p, layer, row, lane);
    }
}

namespace att {
typedef float f32x16 __attribute__((ext_vector_type(16)));
constexpr int KT = 8192, VT = 8192;
constexpr int STAGE = 4 * (KT + VT);
constexpr int OFF_CK = 2 * STAGE;
constexpr int OFF_TAB = OFF_CK + 2 * 4 * 64 * 4;
constexpr int OFF_KM = OFF_TAB + 64 * 8 * 4;
constexpr int LDS_NEED = OFF_KM + 4 * 8 * 64 * 4;
constexpr float NEG = -1e30f, MINIT = -1e20f;
__device__ __forceinline__ int crow(int r, int h) { return (r & 3) + 8 * (r >> 2) + 4 * h; }
__device__ __forceinline__ float pswap_max(float v) { auto r = __builtin_amdgcn_permlane32_swap(__float_as_uint(v), __float_as_uint(v), false, false); return fmaxf(__uint_as_float(r[0]), __uint_as_float(r[1])); }
__device__ __forceinline__ float pswap_sum(float v) { auto r = __builtin_amdgcn_permlane32_swap(__float_as_uint(v), __float_as_uint(v), false, false); return __uint_as_float(r[0]) + __uint_as_float(r[1]); }

template <int KIND>
__device__ __forceinline__ void attn_unit(const Params& p, int layer, LAS unsigned char* lds, int b, int qt) {
    constexpr int NKV = KIND == 0 ? 2 : 4;
    constexpr int NRB = 1;
    constexpr int QR = KIND == 0 ? 32 : 64;
    constexpr int NH = KIND == 0 ? 8 : 4;
    constexpr int QC0 = KIND == 0 ? 0 : (KIND == 1 ? 512 : 768);
    constexpr int KC0 = KIND == 0 ? 0 : (KIND == 1 ? 128 : 384);
    constexpr int VH0 = KIND == 0 ? 0 : (KIND == 1 ? 2 : 6);
    constexpr int NCH = NKV * 512 / NTHREADS;
    const bf16_t* Q = (const bf16_t*)(p.ws + OFF_Q); const bf16_t* Kb = (const bf16_t*)(p.ws + OFF_K); const bf16_t* Vt = (const bf16_t*)(p.ws + OFF_VT);
    bf16_t* Y = (bf16_t*)(p.ws + OFF_Y);
    const float* cwg = (const float*)(p.ws + OFF_CW);
    const int tid = threadIdx.x, lane = tid & 63, wave = __builtin_amdgcn_readfirstlane(tid >> 6), r = lane & 31, h = lane >> 5;
    const int head = KIND == 0 ? wave : (wave >> 1);
    const int kvh = KIND == 0 ? (wave >> 2) : head;
    const int rb0 = KIND == 0 ? 0 : (wave & 1);
    const int q0 = qt * QR;
    const int own = q0 >> 8;
    const int jlo = KIND == 0 ? (q0 >= 127 ? (q0 - 127) >> 6 : 0) : 0;
    const int nt = ((q0 + QR - 1) >> 6) - jlo + 1;
    LAS float* ckb = (LAS float*)(lds + OFF_CK);
    LAS float* tab = (LAS float*)(lds + OFF_TAB);
    LAS float* kmt = (LAS float*)(lds + OFF_KM);

    constexpr int NDMA = NKV * 16 / 8;
    auto dma_tile = [&](int j, int st) {
        const int s0 = (jlo + j) * 64;
#pragma unroll
        for (int q = 0; q < NDMA / 2; ++q) {
            const int id = wave * (NDMA / 2) + q;
            const int hd = id >> 3, i8 = id & 7;
            const int row = 8 * i8 + (lane >> 3), c = (lane & 7) ^ ((row >> 1) & 7);
            __builtin_amdgcn_global_load_lds((const unsigned*)(Kb + ((size_t)b * SEQ + s0 + row) * 640 + KC0 + hd * 64 + c * 8), (LAS unsigned*)(lds + st * STAGE + hd * 8192 + i8 * 1024), 16, 0, 0);
            __builtin_amdgcn_global_load_lds((const unsigned*)(Vt + ((size_t)(b * 10 + VH0 + hd) * 64 + row) * SEQ + s0 + c * 8), (LAS unsigned*)(lds + st * STAGE + 4 * KT + hd * 8192 + i8 * 1024), 16, 0, 0);
        }
        if (KIND == 1 && wave < 4) __builtin_amdgcn_global_load_lds((const unsigned*)(cwg + (size_t)(b * 4 + wave) * SEQ + s0 + lane), (LAS unsigned*)(ckb + st * 256 + wave * 64), 4, 0, 0);
    };
    dma_tile(0, 0);
    bf16x8 qf[NRB][4];
#pragma unroll
    for (int rb = 0; rb < NRB; ++rb) { const size_t row = (size_t)b * SEQ + q0 + 32 * (rb0 + rb) + r;
#pragma unroll
        for (int s4 = 0; s4 < 4; ++s4) qf[rb][s4] = *(const bf16x8*)(Q + row * 1024 + QC0 + head * 64 + 16 * s4 + 8 * h); }
    unsigned selmask = 0;
    if (KIND == 2 && own > 0) {
        const float* km = (const float*)(p.ws + OFF_KMEAN) + (size_t)b * 4 * 8 * 64;
        for (int i = tid; i < 4 * 8 * 64; i += NTHREADS) kmt[i] = km[i];
        __syncthreads();
        float g[8];
#pragma unroll
        for (int j = 0; j < 8; ++j) { float a = 0.f;
            if (j < own) {
#pragma unroll
                for (int s4 = 0; s4 < 4; ++s4) { const LAS f32x4* kp = (const LAS f32x4*)(kmt + (head * 8 + j) * 64 + 16 * s4 + 8 * h); const f32x4 k0 = kp[0], k1 = kp[1];
                    const bf16x8 qq = qf[0][s4];
                    a += bf2f((unsigned short)qq[0]) * k0.x + bf2f((unsigned short)qq[1]) * k0.y + bf2f((unsigned short)qq[2]) * k0.z + bf2f((unsigned short)qq[3]) * k0.w
                       + bf2f((unsigned short)qq[4]) * k1.x + bf2f((unsigned short)qq[5]) * k1.y + bf2f((unsigned short)qq[6]) * k1.z + bf2f((unsigned short)qq[7]) * k1.w; } }
            g[j] = pswap_sum(a); }
        const int nsel = own < 3 ? own : 3;
        for (int rr = 0; rr < nsel; ++rr) { float best = -3.0e38f; int bi = 0;
#pragma unroll
            for (int j = 0; j < 8; ++j) { const bool ok = (j < own) && !((selmask >> j) & 1u); if (ok && g[j] > best) { best = g[j]; bi = j; } }
            selmask |= 1u << bi; }
    }

    float mrun[NRB], lrun[NRB]; f32x16 o[NRB][2];
#pragma unroll
    for (int rb = 0; rb < NRB; ++rb) { mrun[rb] = 0.f; lrun[rb] = 0.f;
#pragma unroll
        for (int d = 0; d < 2; ++d)
#pragma unroll
            for (int e = 0; e < 16; ++e) o[rb][d][e] = 0.f; }

    asm volatile("s_waitcnt vmcnt(0)" ::: "memory");
    __syncthreads();
    auto tile = [&](const LAS unsigned char* kst, const LAS unsigned char* vst, const LAS float* ckt, int s0, bool bnd, float lane_bias) {
        constexpr int rb = 0;
        const int t = q0 + 32 * rb0 + r;
        const float ainit = -mrun[rb];
        f32x16 S[2];
#pragma unroll
        for (int kb = 0; kb < 2; ++kb) { f32x16 a;
#pragma unroll
            for (int e = 0; e < 16; ++e) a[e] = ainit;
#pragma unroll
            for (int s4 = 0; s4 < 4; ++s4) { const int kr = 32 * kb + r; const bf16x8 kf = *(const LAS bf16x8*)(kst + kr * 128 + (((2 * s4 + h) ^ ((kr >> 1) & 7)) << 4));
                a = __builtin_amdgcn_mfma_f32_32x32x16_bf16(kf, qf[rb][s4], a, 0, 0, 0); }
            S[kb] = a; }
        if (KIND == 1) {
#pragma unroll
            for (int kb = 0; kb < 2; ++kb)
#pragma unroll
                for (int g4 = 0; g4 < 4; ++g4) { const f32x4 ckv = *(const LAS f32x4*)(ckt + 32 * kb + 8 * g4 + 4 * h);
#pragma unroll
                    for (int e = 0; e < 4; ++e) S[kb][4 * g4 + e] -= ckv[e]; }
        }
        if (KIND == 2 && __any(lane_bias != 0.f)) {
#pragma unroll
            for (int kb = 0; kb < 2; ++kb)
#pragma unroll
                for (int e = 0; e < 16; ++e) S[kb][e] += lane_bias;
        }
        if (bnd) {
#pragma unroll
            for (int kb = 0; kb < 2; ++kb)
#pragma unroll
                for (int reg = 0; reg < 16; ++reg) { const int key = s0 + 32 * kb + crow(reg, h);
                    const bool ok = (KIND == 0) ? ((key <= t) && (t - key < 128)) : (key <= t);
                    S[kb][reg] = ok ? S[kb][reg] : NEG; }
        }
        float mx = S[0][0];
#pragma unroll
        for (int e = 1; e < 16; ++e) mx = fmaxf(mx, S[0][e]);
#pragma unroll
        for (int e = 0; e < 16; ++e) mx = fmaxf(mx, S[1][e]);
        mx = pswap_max(mx);
        const bool mv = (mx > 8.0f) || (lrun[rb] == 0.f && mx < -8.0f && mx > -1e29f);
        if (__any(mv)) {
            const float delta = mv ? mx : 0.f;
            const float alpha = lrun[rb] == 0.f ? 1.0f : __builtin_amdgcn_exp2f(-delta);
            lrun[rb] *= alpha;
#pragma unroll
            for (int d = 0; d < 2; ++d)
#pragma unroll
                for (int e = 0; e < 16; ++e) o[rb][d][e] *= alpha;
            mrun[rb] += delta;
#pragma unroll
            for (int kb = 0; kb < 2; ++kb)
#pragma unroll
                for (int e = 0; e < 16; ++e) S[kb][e] -= delta;
        }
        float ps = 0.f;
#pragma unroll
        for (int kb = 0; kb < 2; ++kb)
#pragma unroll
            for (int e = 0; e < 16; ++e) { const float pv = __builtin_amdgcn_exp2f(S[kb][e]); S[kb][e] = pv; ps += pv; }
        lrun[rb] += ps;
        bf16x8 pb[2][2];
#pragma unroll
        for (int kb = 0; kb < 2; ++kb)
#pragma unroll
            for (int s2 = 0; s2 < 2; ++s2) { u32x4 w; w.x = pk2(S[kb][8 * s2 + 0], S[kb][8 * s2 + 1]); w.y = pk2(S[kb][8 * s2 + 2], S[kb][8 * s2 + 3]);
                w.z = pk2(S[kb][8 * s2 + 4], S[kb][8 * s2 + 5]); w.w = pk2(S[kb][8 * s2 + 6], S[kb][8 * s2 + 7]); pb[kb][s2] = __builtin_bit_cast(bf16x8, w); }
#pragma unroll
        for (int d = 0; d < 2; ++d)
#pragma unroll
            for (int kb = 0; kb < 2; ++kb)
#pragma unroll
                for (int s2 = 0; s2 < 2; ++s2) { const int dr = 32 * d + r, sw = (dr >> 1) & 7, c0 = 4 * kb + 2 * s2 + h;
                    const u32x4 vv = *(const LAS u32x4*)(vst + dr * 128 + ((c0 ^ sw) << 4));
                    o[rb][d] = __builtin_amdgcn_mfma_f32_32x32x16_bf16(__builtin_bit_cast(bf16x8, vv), pb[kb][s2], o[rb][d], 0, 0, 0); }
    };
    for (int j = 0; j < nt; ++j) {
        if (j + 1 < nt) dma_tile(j + 1, (j + 1) & 1);
        const int st = j & 1, s0 = (jlo + j) * 64;
        const LAS unsigned char* kst = lds + st * STAGE + kvh * KT;
        const LAS unsigned char* vst = lds + st * STAGE + 4 * KT + kvh * VT;
        const LAS float* ckt = ckb + st * 256 + kvh * 64;
        const bool moba_past = (KIND == 2) && ((s0 >> 8) != own);
        const bool lane_sel = (KIND == 2 && moba_past) ? (((selmask >> (s0 >> 8)) & 1u) != 0u) : true;
        bool bnd;
        if (KIND == 0) bnd = !((s0 + 63 <= q0) && (s0 >= q0 + 31 - 127));
        else bnd = (s0 + 63 > q0 + 32 * rb0);
        if (!(moba_past && !__any(lane_sel))) tile(kst, vst, ckt, s0, bnd, lane_sel ? 0.f : NEG);
        asm volatile("s_waitcnt vmcnt(0)" ::: "memory");
        __syncthreads();
    }
    float ssq_part[NRB];
#pragma unroll
    for (int rb = 0; rb < NRB; ++rb) {
        float l = pswap_sum(lrun[rb]);
        if (KIND == 0) l += __builtin_amdgcn_exp2f(p.in[4][layer * 8 + head] * LOG2E - mrun[rb]);
        const float inv = 1.0f / l; float ss = 0.f;
#pragma unroll
        for (int d = 0; d < 2; ++d)
#pragma unroll
            for (int e = 0; e < 16; ++e) { const float v = o[rb][d][e] * inv; o[rb][d][e] = v; ss += v * v; }
        ss = pswap_sum(ss); ssq_part[rb] = ss;
        if (h == 0) tab[(32 * (rb0 + rb) + r) * 8 + head] = ss;
    }
    __syncthreads();
#pragma unroll
    for (int rb = 0; rb < NRB; ++rb) {
        const int ql = 32 * (rb0 + rb) + r;
        float tot = 0.f;
#pragma unroll
        for (int hh = 0; hh < NH; ++hh) tot += tab[ql * 8 + hh];
        const float sc = 1.0f / sqrtf(tot * (1.0f / (NH * 64)) + RMS_EPS);
        bf16_t* yp = Y + ((size_t)b * SEQ + q0 + ql) * 1024 + QC0 + head * 64;
#pragma unroll
        for (int d = 0; d < 2; ++d)
#pragma unroll
            for (int g4 = 0; g4 < 4; ++g4) { u32x2 w; w.x = pk2(o[rb][d][4 * g4] * sc, o[rb][d][4 * g4 + 1] * sc); w.y = pk2(o[rb][d][4 * g4 + 2] * sc, o[rb][d][4 * g4 + 3] * sc);
                *(u32x2*)(yp + 32 * d + 8 * g4 + 4 * h) = w; }
    }
    (void)ssq_part;
    __syncthreads();
}

__device__ __forceinline__ void phase_attn(const Params& p, int layer, LAS unsigned char* lds) {
    for (int i = blockIdx.x; i < 256; i += gridDim.x) {
#pragma unroll 1
        for (int k = 0; k < 2; ++k) { const int j = k == 0 ? i : 511 - i; const int qt = 31 - (j >> 4), w = j & 15, b = w >> 1;
            if (w & 1) attn_unit<2>(p, layer, lds, b, qt); else attn_unit<1>(p, layer, lds, b, qt); }
        attn_unit<0>(p, layer, lds, i >> 5, 2 * (i & 31));
        attn_unit<0>(p, layer, lds, i >> 5, 2 * (i & 31) + 1);
    }
}
}

__device__ __forceinline__ void phase_top2(const Params& p, LAS unsigned char* lds) {
    const int tid = threadIdx.x, lane = tid & 63, wave = tid >> 6;
    const float* plog = (const float*)(p.ws + OFF_PLOG); const float* ssq = (const float*)(p.ws + OFF_SSQB);
    int* toke = (int*)(p.ws + OFF_TOKE); float* tokg = (float*)(p.ws + OFF_TOKG); int* ghist = (int*)(p.ws + OFF_CTL) + 16384;
    LAS int* hist = (LAS int*)lds;
    for (int k = blockIdx.x; k < T_TOK / 64; k += gridDim.x) {
        if (tid < 8) hist[tid] = 0;
        __syncthreads();
        int hc[8];
#pragma unroll
        for (int e = 0; e < 8; ++e) hc[e] = 0;
#pragma unroll
        for (int half = 0; half < 2; ++half) {
            f32x2 v[4]; float q[4];
#pragma unroll
            for (int u = 0; u < 4; ++u) { const int tok = 64 * k + 8 * wave + 4 * half + u;
                v[u] = *(const f32x2*)(plog + (size_t)tok * 128 + 2 * lane);
                q[u] = ssq[(size_t)tok * 16 + (lane & 15)]; }
#pragma unroll
            for (int u = 0; u < 4; ++u) {
                const int tok = 64 * k + 8 * wave + 4 * half + u;
                float a = v[u].x, b = v[u].y, s2 = q[u];
#pragma unroll
                for (int o = 4; o < 64; o <<= 1) { a += __shfl_xor(a, o); b += __shfl_xor(b, o); }
#pragma unroll
                for (int o = 1; o < 16; o <<= 1) s2 += __shfl_xor(s2, o);
                const float rs = __builtin_amdgcn_rsqf(s2 * (1.0f / DM) + RMS_EPS);
                float lg[8];
#pragma unroll
                for (int e = 0; e < 8; ++e) lg[e] = __shfl((e & 1) ? b : a, e >> 1) * rs;
                float v0 = -3.0e38f, v1 = -3.0e38f; int e0 = 0, e1 = 0;
#pragma unroll
                for (int e = 0; e < 8; ++e) { const float x = lg[e]; if (x > v0) { v1 = v0; e1 = e0; v0 = x; e0 = e; } else if (x > v1) { v1 = x; e1 = e; } }
                const float g0 = 1.0f / (1.0f + __expf(v1 - v0)), g1 = 1.0f - g0;
                if (lane == 0) { *(u32x2*)(toke + tok * 2) = (u32x2){(unsigned)e0, (unsigned)e1}; *(f32x2*)(tokg + tok * 2) = (f32x2){g0, g1}; }
#pragma unroll
                for (int e = 0; e < 8; ++e) hc[e] += (e == e0) + (e == e1);
            }
        }
        if (lane < 8) { int c = 0;
#pragma unroll
            for (int e = 0; e < 8; ++e) if (lane == e) c = hc[e];
            __hip_atomic_fetch_add((int*)(hist + lane), c, __ATOMIC_RELAXED, __HIP_MEMORY_SCOPE_WORKGROUP); }
        __syncthreads();
        if (tid < 8) ghist[k * 8 + tid] = hist[tid];
        __syncthreads();
    }
}

__device__ __forceinline__ void phase_slot(const Params& p, LAS unsigned char* lds) {
    const int tid = threadIdx.x, lane = tid & 63, wave = tid >> 6;
    int* cnt = (int*)(p.ws + OFF_CTL); const int* toke = (const int*)(p.ws + OFF_TOKE); int* tokp = (int*)(p.ws + OFF_TOKP); int* idx = (int*)(p.ws + OFF_IDX);
    const int* ghist = (const int*)(p.ws + OFF_CTL) + 16384;
    LAS int* hist = (LAS int*)lds;
    for (int k = blockIdx.x; k < T_TOK / 64; k += gridDim.x) {
        if (tid < 8) hist[tid] = 0;
        __syncthreads();
        { int c = 0;
#pragma unroll
            for (int i = 0; i < 4; ++i) { const int g = (tid >> 3) + 64 * i; if (g < k) c += ghist[g * 8 + (tid & 7)]; }
            if (c) __hip_atomic_fetch_add((int*)(hist + (tid & 7)), c, __ATOMIC_RELAXED, __HIP_MEMORY_SCOPE_WORKGROUP); }
        __syncthreads();
        if (wave == 0) {
            const int tok = 64 * k + lane; const u32x2 ee = *(const u32x2*)(toke + tok * 2);
            const float rs_tok = rstd_from_ssq((const float*)(p.ws + OFF_SSQB), tok); float* rse = (float*)(p.ws + OFF_RSE);
#pragma unroll
            for (int e = 0; e < 8; ++e) {
                const bool m0 = (int)ee.x == e, m1 = (int)ee.y == e, m = m0 || m1;
                const unsigned long long bal = __ballot(m);
                const int pre = __popcll(bal & ((1ull << lane) - 1ull));
                const int base = hist[e];
                if (m) { const int pos = base + pre; idx[(size_t)e * T_TOK + pos] = tok; tokp[tok * 2 + (m0 ? 0 : 1)] = pos; rse[(size_t)e * T_TOK + pos] = rs_tok; }
                if (k == T_TOK / 64 - 1 && lane == 0) cnt[e] = base + __popcll(bal);
            }
        }
        __syncthreads();
    }
}

__device__ __forceinline__ void phase_final(const Params& p, float* dst_override = nullptr) {
    const int tid = threadIdx.x, lane = tid & 63, wave = tid >> 6;
    const int gw = blockIdx.x * NWAVES + wave, NGW = gridDim.x * NWAVES;
    const int* cnt = (const int*)(p.ws + OFF_CTL); const int* toke = (const int*)(p.ws + OFF_TOKE); const int* tokp = (const int*)(p.ws + OFF_TOKP); const float* tokg = (const float*)(p.ws + OFF_TOKG);
    const float* fn = p.in[15];
    int base[8], tb[8], nr8[8], lfull; { int b = 0, t = 0;
#pragma unroll
        for (int e = 0; e < 8; ++e) { base[e] = b; b += cnt[e]; nr8[e] = (cnt[e] + 255) >> 8; tb[e] = t; t += nr8[e] * 4; }
        const int G_ = gridDim.x, rem = t % G_; lfull = (rem > 0 && 4 * rem <= G_) ? (t / G_) * G_ : 0x7fffffff; }
    const bf16_t* side = (const bf16_t*)(p.ws + EpiY::OFF_SIDE);
    f32x4 gfn[4];
#pragma unroll
    for (int j = 0; j < 4; ++j) gfn[j] = *(const f32x4*)(fn + 4 * lane + 256 * j);
    constexpr int NR = 2;
    for (int row0 = gw; row0 < T_TOK; row0 += NR * NGW) {
        int rowv[NR]; bool okv[NR]; int r0v[NR], r1v[NR]; float g0v[NR], g1v[NR]; int t0v[NR], t1v[NR], n0v[NR], n1v[NR], p0v[NR], p1v[NR];
#pragma unroll
        for (int u = 0; u < NR; ++u) { const int row = row0 + u * NGW; okv[u] = row < T_TOK; rowv[u] = okv[u] ? row : row0;
            const u32x2 ee = *(const u32x2*)(toke + rowv[u] * 2), pp = *(const u32x2*)(tokp + rowv[u] * 2); const f32x2 gg = *(const f32x2*)(tokg + rowv[u] * 2);
            int b0 = 0, b1 = 0, q0 = 0, q1 = 0, m0 = 1, m1 = 1;
#pragma unroll
            for (int e = 0; e < 8; ++e) { if (e == (int)ee.x) { b0 = base[e]; q0 = tb[e]; m0 = nr8[e]; } if (e == (int)ee.y) { b1 = base[e]; q1 = tb[e]; m1 = nr8[e]; } }
            r0v[u] = b0 + (int)pp.x; r1v[u] = b1 + (int)pp.y; g0v[u] = gg.x; g1v[u] = gg.y;
            t0v[u] = q0 + ((int)pp.x >> 8); t1v[u] = q1 + ((int)pp.y >> 8); n0v[u] = m0; n1v[u] = m1; p0v[u] = (int)pp.x & 255; p1v[u] = (int)pp.y & 255; }
        f32x4 v[NR][4]; u32x2 ya[NR][4], yc[NR][4], ya2[NR][4], yc2[NR][4];
#pragma unroll
        for (int u = 0; u < NR; ++u) {
            const u32x2* xr = (const u32x2*)((const bf16_t*)(p.ws + OFF_HB) + (size_t)rowv[u] * DM) + lane;
            const u32x2* y0 = (const u32x2*)EpiY::yrow(p.ws, r0v[u]) + lane; const u32x2* y1 = (const u32x2*)EpiY::yrow(p.ws, r1v[u]) + lane;
#pragma unroll
            for (int j = 0; j < 4; ++j) { const u32x2 hw = xr[64 * j]; v[u][j] = (f32x4){bflo(hw.x), bfhi(hw.x), bflo(hw.y), bfhi(hw.y)}; ya[u][j] = y0[64 * j]; yc[u][j] = y1[64 * j];
                const int L0 = t0v[u] + j * n0v[u], L1 = t1v[u] + j * n1v[u];
                ya2[u][j] = L0 >= lfull ? *((const u32x2*)(side + ((size_t)(L0 - lfull) * 256 + p0v[u]) * 256) + lane) : (u32x2){0u, 0u};
                yc2[u][j] = L1 >= lfull ? *((const u32x2*)(side + ((size_t)(L1 - lfull) * 256 + p1v[u]) * 256) + lane) : (u32x2){0u, 0u}; }
        }
#pragma unroll
        for (int u = 0; u < NR; ++u) {
            const float g0 = g0v[u], g1 = g1v[u]; float ss = 0.f;
#pragma unroll
            for (int j = 0; j < 4; ++j) { const u32x2 a = ya[u][j], c = yc[u][j], a2 = ya2[u][j], c2 = yc2[u][j];
                v[u][j].x += g0 * (bflo(a.x) + bflo(a2.x)) + g1 * (bflo(c.x) + bflo(c2.x)); v[u][j].y += g0 * (bfhi(a.x) + bfhi(a2.x)) + g1 * (bfhi(c.x) + bfhi(c2.x));
                v[u][j].z += g0 * (bflo(a.y) + bflo(a2.y)) + g1 * (bflo(c.y) + bflo(c2.y)); v[u][j].w += g0 * (bfhi(a.y) + bfhi(a2.y)) + g1 * (bfhi(c.y) + bfhi(c2.y));
                ss += (v[u][j].x * v[u][j].x + v[u][j].y * v[u][j].y) + (v[u][j].z * v[u][j].z + v[u][j].w * v[u][j].w); }
            ss = wave_sum(ss);
            const float rstd = 1.0f / sqrtf(ss * (1.0f / DM) + RMS_EPS);
            if (okv[u]) {
                f32x4* xw = (f32x4*)((dst_override ? dst_override : p.out) + (size_t)rowv[u] * DM) + lane;
#pragma unroll
                for (int j = 0; j < 4; ++j) xw[64 * j] = v[u][j] * rstd * gfn[j];
            }
        }
    }
}

#define XB_TMO      128
#define XB_XCNT(j)  (256  + 64 * (j))
#define XB_XSUB(j)  (1280 + 64 * (j))
#define XB_XGEN(j)  (2304 + 64 * (j))
#define XB_TOP      3328
#define XB_TOPGEN   3392
#define XCD_BAR_WORDS 3456
#define XB_SPIN_CAP (1u << 18)
__device__ __forceinline__ unsigned xb_ld(unsigned* p)              { return __hip_atomic_load(p, __ATOMIC_RELAXED, __HIP_MEMORY_SCOPE_AGENT); }
__device__ __forceinline__ unsigned xb_add(unsigned* p, unsigned v) { return __hip_atomic_fetch_add(p, v, __ATOMIC_RELAXED, __HIP_MEMORY_SCOPE_AGENT); }
__device__ __forceinline__ unsigned xb_xcc_id() { return (unsigned)__builtin_amdgcn_s_getreg((3 << 11) | 20) & 0xFu; }
#define XB_SPIN(cond, bar) do { unsigned _sp = 0; while (cond) { __builtin_amdgcn_s_sleep(1); \
    if ((++_sp & 255u) == 0u) { if (xb_ld(&(bar)[XB_TMO])) break; if (_sp > XB_SPIN_CAP) { atomicAdd(&(bar)[XB_TMO], 1u); break; } } } } while (0)
struct XcdBarrier { unsigned* bar; unsigned x; volatile LAS unsigned* st; };
__device__ __forceinline__ XcdBarrier xcd_barrier_post(unsigned* bar, volatile LAS unsigned* st) {
    XcdBarrier b; b.bar = bar; b.x = xb_xcc_id(); b.st = st;
    if (threadIdx.x == 0) (void)xb_add(&bar[XB_XCNT(b.x)], 1u);
    return b;
}
__device__ __forceinline__ void xcd_barrier_complete(unsigned* bar, unsigned x, unsigned& nloc, unsigned& nx) {
    const unsigned G = gridDim.x * gridDim.y * gridDim.z;
    unsigned sum, cnt, mine, sp = 0u;
    for (;;) {
        sum = 0u; cnt = 0u; mine = 0u;
#pragma unroll
        for (unsigned j = 0; j < 16; ++j) { const unsigned c = xb_ld(&bar[XB_XCNT(j)]); sum += c; cnt += (c > 0u) ? 1u : 0u; mine = (j == x) ? c : mine; }
        if (sum == G) break;
        __builtin_amdgcn_s_sleep(1);
        if ((++sp & 255u) == 0u) { if (xb_ld(&bar[XB_TMO])) break; if (sp > XB_SPIN_CAP) { atomicAdd(&bar[XB_TMO], 1u); break; } }
    }
    nloc = mine > 0u ? mine : 1u; nx = cnt > 0u ? cnt : 1u;
}
__device__ __forceinline__ void xcd_barrier(const XcdBarrier& b) {
    asm volatile("s_waitcnt vmcnt(0)" ::: "memory");
    __syncthreads();
    if (threadIdx.x == 0) {
        unsigned* bar = b.bar;
        __builtin_amdgcn_s_waitcnt(0);
        unsigned nloc = b.st[0], nx = b.st[1];
        if (nloc == 0u) { xcd_barrier_complete(bar, b.x, nloc, nx); b.st[0] = nloc; b.st[1] = nx; }
        const unsigned old = xb_add(&bar[XB_XSUB(b.x)], 1u);
        const unsigned gen = old / nloc;
        if (old + 1u == (gen + 1u) * nloc) {
            __builtin_amdgcn_fence(__ATOMIC_RELEASE, "agent");
            asm volatile("s_waitcnt vmcnt(0)" ::: "memory");
            const unsigned og = xb_add(&bar[XB_TOP], 1u);
            const unsigned tg = og / nx;
            if (og + 1u == (tg + 1u) * nx) xb_add(&bar[XB_TOPGEN], 1u);
            else XB_SPIN(xb_ld(&bar[XB_TOPGEN]) == tg, bar);
            __builtin_amdgcn_fence(__ATOMIC_ACQUIRE, "agent");
            xb_add(&bar[XB_XGEN(b.x)], 1u);
            asm volatile("s_waitcnt vmcnt(0)" ::: "memory");
        } else {
            XB_SPIN(xb_ld(&bar[XB_XGEN(b.x)]) == gen, bar);
            __builtin_amdgcn_fence(__ATOMIC_ACQUIRE, "agent");
            asm volatile("s_waitcnt vmcnt(0)" ::: "memory");
        }
    }
    __syncthreads();
}

__device__ __forceinline__ void phase_dbg_hash(const Params& p, const unsigned* buf, size_t nwords) {
    const int tid = threadIdx.x, lane = tid & 63, wave = tid >> 6;
    const int gw = blockIdx.x * NWAVES + wave, NGW = gridDim.x * NWAVES;
    const size_t cw = nwords / T_TOK;
    for (int row = gw; row < T_TOK; row += NGW) {
        const unsigned* b = buf + (size_t)row * cw;
        unsigned h = 0x9e3779b9u;
        for (size_t i = lane; i < cw; i += 64) { h = (h ^ __hip_atomic_load(b + i, __ATOMIC_RELAXED, __HIP_MEMORY_SCOPE_SYSTEM)) * 0x01000193u; h ^= h >> 15; }
#pragma unroll
        for (int o = 1; o < 64; o <<= 1) h = (h * 31u) ^ (unsigned)__shfl_xor((int)h, o);
        const float v = (float)(h & 0xffffu) * (1.0f / 65536.0f);
        f32x4* xr = (f32x4*)(p.out + (size_t)row * DM) + lane;
#pragma unroll
        for (int j = 0; j < 4; ++j) xr[64 * j] = (f32x4){v, v, v, v};
    }
}

enum { PH_PRO = 0, PH_IN0, PH_KM0, PH_AT0, PH_OUT0, PH_G1_0, PH_G2_0, PH_IN1, PH_KM1, PH_AT1, PH_OUT1, PH_ROUTER, PH_SLOT, PH_MG1, PH_MG2, PH_FINAL, NPHASES };

#if USE_FAST_GEMM
#define GEMM(A_, B_, K_, S_, E_) pg::gemm_fast<false>(lds, A_, B_, K_, K_, S_, E_)
#define GEMMH(A_, B_, K_, S_, E_) pg::gemm_fast<true>(lds, A_, B_, K_, K_, S_, E_)
#define GEMMK(A_, B_, K_, KL_, S_, E_) pg::gemm_fast<false>(lds, A_, B_, K_, KL_, S_, E_)
#define GEMMKH(A_, B_, K_, KL_, S_, E_) pg::gemm_fast<true>(lds, A_, B_, K_, KL_, S_, E_)
#else
#define GEMM(A_, B_, K_, S_, E_) gemm_simple(A_, B_, K_, K_, S_, E_)
#define GEMMH(A_, B_, K_, S_, E_) gemm_simple(A_, B_, K_, K_, S_, E_)
#define GEMMK(A_, B_, K_, KL_, S_, E_) gemm_simple(A_, B_, K_, KL_, S_, E_)
#define GEMMKH(A_, B_, K_, KL_, S_, E_) gemm_simple(A_, B_, K_, KL_, S_, E_)
#endif
template <int PH>
__device__ __forceinline__ void run_phase(const Params& p, LAS unsigned char* lds) {
    unsigned char* ws = p.ws;
    const int G = gridDim.x, bid = blockIdx.x;
    if constexpr (PH == PH_PRO) { phase_prologue(p, lds); }
    else if constexpr (PH == PH_IN0 || PH == PH_IN1) {
        constexpr int l = PH == PH_IN0 ? 0 : 1;
        DenseSched S; S.init(T_TOK, NIN, G, bid, 1);
        DenseSched S2; S2.init(T_TOK, NIN, G, bid, 2);
        EpiInProj E{(const float*)(ws + OFF_SSQA), (const float*)(ws + OFF_ROPE), (const float*)(ws + OFF_ROPE) + SEQ * 32, (bf16_t*)(ws + OFF_Q), (bf16_t*)(ws + OFF_K), (bf16_t*)(ws + OFF_VT),
                    (float*)(ws + OFF_LOGF), p.in[3] + l * 4};
        GEMM((const bf16_t*)(ws + OFF_HB), (const bf16_t*)(ws + OFF_WIN) + (size_t)l * NIN * DM, DM, S, E);
        GEMMH((const bf16_t*)(ws + OFF_HB), (const bf16_t*)(ws + OFF_WIN) + (size_t)l * NIN * DM, DM, S2, E);
    }
    else if constexpr (PH == PH_KM0 || PH == PH_KM1) { phase_kmean(p, lds); phase_scan(p, lds); }
    else if constexpr (PH == PH_AT0 || PH == PH_AT1) {
#if USE_FAST_ATTN
        att::phase_attn(p, PH == PH_AT0 ? 0 : 1, lds);
#else
        phase_attn_naive(p, PH == PH_AT0 ? 0 : 1);
#endif
    }
    else if constexpr (PH == PH_OUT0 || PH == PH_OUT1) {
        constexpr int l = PH == PH_OUT0 ? 0 : 1;
        DenseSched S; S.init(T_TOK, DM, G, bid);
        EpiResid<(l == 1)> E{(bf16_t*)(ws + OFF_HB), (float*)(ws + OFF_SSQB), (const float*)(ws + OFF_WRT), (float*)(ws + OFF_PLOG)};
        GEMM((const bf16_t*)(ws + OFF_Y), (const bf16_t*)(ws + OFF_WOUT) + (size_t)l * DM * DM, DM, S, E);
    }
    else if constexpr (PH == PH_G1_0) {
        DenseSched S; S.init(T_TOK, 2 * FF, G, bid);
        EpiSwiGLU<false> E{(const float*)(ws + OFF_SSQB), (bf16_t*)(ws + OFF_DACT)};
        GEMM((const bf16_t*)(ws + OFF_HB), (const bf16_t*)(ws + OFF_DGU), DM, S, E);
    }
    else if constexpr (PH == PH_G2_0) {
        DenseSched S; S.init(T_TOK, DM, G, bid);
        EpiResid<false> E{(bf16_t*)(ws + OFF_HB), (float*)(ws + OFF_SSQA), nullptr, nullptr};
        GEMM((const bf16_t*)(ws + OFF_DACT), (const bf16_t*)(ws + OFF_DDN), FF, S, E);
    }
    else if constexpr (PH == PH_ROUTER) {
        phase_top2(p, lds);
        conv_range(p, lds, NITEMS_EARLY, NITEMS_EARLY + NITEMS_MOE);
    }
    else if constexpr (PH == PH_SLOT) { phase_slot(p, lds); }
    else if constexpr (PH == PH_MG1) {
        MoeSched S; S.init((const int*)(ws + OFF_CTL), (const int*)(ws + OFF_IDX), 28, 2 * FF, G, bid, true, 1, 0, 1);
        S.rse = (const float*)(ws + OFF_RSE);
        MoeSched S2; S2.init((const int*)(ws + OFF_CTL), (const int*)(ws + OFF_IDX), 28, 2 * FF, G, bid, true, 1, 0, 2);
        S2.rse = (const float*)(ws + OFF_RSE);
        EpiSwiGLU<true> E{nullptr, (bf16_t*)(ws + OFF_MACT)};
        GEMM((const bf16_t*)(ws + OFF_HB), (const bf16_t*)(ws + OFF_MGU), DM, S, E);
        GEMMH((const bf16_t*)(ws + OFF_HB), (const bf16_t*)(ws + OFF_MGU), DM, S2, E);
    }
    else if constexpr (PH == PH_MG2) {
        MoeSched S; S.init((const int*)(ws + OFF_CTL), (const int*)(ws + OFF_IDX), 4, DM, G, bid, false, 1, FF / 2, 1, true);
        MoeSched S2; S2.init((const int*)(ws + OFF_CTL), (const int*)(ws + OFF_IDX), 4, DM, G, bid, false, 1, FF / 2, 2, true);
        EpiY E{ws};
        GEMMK((const bf16_t*)(ws + OFF_MACT), (const bf16_t*)(ws + OFF_MDN), FF, FF, S, E);
        GEMMKH((const bf16_t*)(ws + OFF_MACT), (const bf16_t*)(ws + OFF_MDN), FF, FF / 2, S2, E);
    }
    else if constexpr (PH == PH_FINAL) {
#ifdef DBG_FINAL_TWICE
        phase_final(p, (float*)(p.ws + OFF_Q));
#endif
        phase_final(p); }
}

template <int PH>
__global__ void __launch_bounds__(NTHREADS) mk_phase(Params p) {
    extern __shared__ __attribute__((aligned(16))) unsigned char lds_raw[];
    run_phase<PH>(p, (LAS unsigned char*)lds_raw);
}

#if !MK_MULTI
template <int PH>
__device__ __forceinline__ void run_from(const Params& p, LAS unsigned char* lds, cg::grid_group& grid, const XcdBarrier& xb) {
    if constexpr (PH < NPHASES) {
        if (PH >= p.ph_lo && PH < p.ph_hi) {
            if (PH > p.ph_lo) xcd_barrier(xb);
            run_phase<PH>(p, lds);
#ifdef DBG_REPEAT_MASK
            if ((DBG_REPEAT_MASK >> PH) & 1) { xcd_barrier(xb); run_phase<PH>(p, lds); }
#endif
        }
        run_from<PH + 1>(p, lds, grid, xb);
    }
}
__global__ void __launch_bounds__(NTHREADS) mk_fwd(Params p) {
    extern __shared__ __attribute__((aligned(16))) unsigned char lds_raw[];
    cg::grid_group grid = cg::this_grid();
    volatile LAS unsigned* xst = (volatile LAS unsigned*)((LAS unsigned char*)lds_raw + LDS_BYTES - 64);
    if (threadIdx.x < 2) xst[threadIdx.x] = 0u;
    __syncthreads();
    const XcdBarrier xb = xcd_barrier_post((unsigned*)(p.ws + OFF_CTL) + 1024, xst);
    if (p.ph_hi < 0) grid.sync();
    run_from<0>(p, (LAS unsigned char*)lds_raw, grid, xb);
#ifdef DBG_EXTRA_BARS
    for (int i = 0; i < DBG_EXTRA_BARS; ++i) xcd_barrier(xb);
#endif
#ifdef DBG_TWICE
    forget_pass(p, 0, 440 * MiB);
    grid.sync();
    {
        const unsigned* a = (const unsigned*)(p.ws + OFF_LOGF); const unsigned* b2 = (const unsigned*)(p.ws + OFF_LOGF + 440 * MiB);
        const int gt = blockIdx.x * NTHREADS + threadIdx.x;
        if (gt < 131072) { const float f = (a[gt] != b2[gt]) ? 1.0f : 0.0f; for (int k = 0; k < 128; ++k) p.out[(size_t)gt * 128 + k] = f; }
    }
#elif defined(DBG_HASH_SEL)
    xcd_barrier(xb);
    {
        constexpr int sel = DBG_HASH_SEL;
        const unsigned* b; size_t nw;
        if (sel == 0) { b = (const unsigned*)p.out; nw = (size_t)T_TOK * 1024; }
        else if (sel == 20) { b = (const unsigned*)p.in[0]; nw = (size_t)T_TOK * 1024; }
        else if (sel == 21) { b = (const unsigned*)p.in[2]; nw = (size_t)T_TOK * 288; }
        else if (sel == 1) { b = (const unsigned*)(p.ws + OFF_HB); nw = (size_t)T_TOK * 512; }
        else if (sel == 2) { b = (const unsigned*)(p.ws + OFF_Q); nw = (size_t)T_TOK * 512; }
        else if (sel == 3) { b = (const unsigned*)(p.ws + OFF_K); nw = (size_t)T_TOK * 640; }
        else if (sel == 4) { b = (const unsigned*)(p.ws + OFF_VT); nw = (size_t)T_TOK * 320; }
        else if (sel == 5) { b = (const unsigned*)(p.ws + OFF_Y); nw = (size_t)T_TOK * 512; }
        else if (sel == 6) { b = (const unsigned*)(p.ws + OFF_SSQA); nw = (size_t)T_TOK * 16; }
        else if (sel == 7) { b = (const unsigned*)(p.ws + OFF_SSQB); nw = (size_t)T_TOK * 16; }
        else if (sel == 8) { b = (const unsigned*)(p.ws + OFF_WIN); nw = (size_t)T_TOK * 544; }
        else if (sel == 9) { b = (const unsigned*)(p.ws + OFF_MGU); nw = (size_t)T_TOK * 1792; }
        else if (sel == 10) { b = (const unsigned*)(p.ws + OFF_MDN); nw = (size_t)T_TOK * 896; }
        else if (sel == 11) { b = (const unsigned*)(p.ws + OFF_DACT); nw = (size_t)T_TOK * 1792; }
        else if (sel == 12) { b = (const unsigned*)(p.ws + OFF_ROPE); nw = (size_t)T_TOK * 8; }
        else if (sel == 13) { b = (const unsigned*)(p.ws + OFF_LOGF); nw = (size_t)T_TOK * 4; }
        else { b = (const unsigned*)(p.ws + OFF_KMEAN); nw = (size_t)T_TOK * 1; }
        phase_dbg_hash(p, b, nw);
    }
#endif
}
#endif

template <int PH> static void launch_phase(const Params& p, int grid, hipStream_t stream) {
    static bool attr_done = false;
    if (!attr_done) { (void)hipFuncSetAttribute((const void*)mk_phase<PH>, hipFuncAttributeMaxDynamicSharedMemorySize, LDS_BYTES); attr_done = true; }
    hipLaunchKernelGGL(mk_phase<PH>, dim3(grid), dim3(NTHREADS), LDS_BYTES, stream, p);
}
#ifndef DBG_NPH
#define DBG_NPH NPHASES
#endif
template <int PH> static void launch_all(const Params& p, int grid, hipStream_t stream) {
    if constexpr (PH < DBG_NPH) { launch_phase<PH>(p, grid, stream); launch_all<PH + 1>(p, grid, stream); }
}

extern "C" void kernel_launch(void* const* d_in, const int* in_sizes, int n_in, void* d_out, int out_size, void* d_ws, size_t ws_size, hipStream_t stream) {
    static int grid = 0;
    if (grid == 0) {
        int dev = 0, cus = 0;
        (void)hipGetDevice(&dev);
        (void)hipDeviceGetAttribute(&cus, hipDeviceAttributeMultiprocessorCount, dev);
#if !MK_MULTI
        int per_cu = 0;
        (void)hipFuncSetAttribute((const void*)mk_fwd, hipFuncAttributeMaxDynamicSharedMemorySize, LDS_BYTES);
        (void)hipOccupancyMaxActiveBlocksPerMultiprocessor(&per_cu, (const void*)mk_fwd, NTHREADS, LDS_BYTES);
        if (per_cu < 1) fprintf(stderr, "kernel_launch: occupancy query says %d blocks/CU\n", per_cu);
#endif
        grid = cus;
        if (n_in != 16 || ws_size < WS_NEED) fprintf(stderr, "kernel_launch: unexpected n_in %d or ws_size %zu (< %zu)\n", n_in, ws_size, (size_t)WS_NEED);
    }
    if (ws_size < WS_NEED || n_in != 16) return;
    (void)hipMemsetAsync((char*)d_ws + OFF_CTL, 0, CTL_BYTES, stream);
    Params p{};
    for (int i = 0; i < 16; ++i) p.in[i] = (const float*)d_in[i];
    p.out = (float*)d_out; p.ws = (unsigned char*)d_ws;
#if MK_MULTI
    p.ph_lo = 0; p.ph_hi = NPHASES;
    launch_all<0>(p, grid, stream);
#else
    p.ph_lo = 0; p.ph_hi = DBG_NPH;
    void* args[] = {&p};
    hipError_t e = hipLaunchCooperativeKernel((const void*)mk_fwd, dim3(grid), dim3(NTHREADS), args, LDS_BYTES, stream);
    if (e != hipSuccess) fprintf(stderr, "cooperative launch failed: %s (grid %d)\n", hipGetErrorString(e), grid);
#endif
}
#ifdef ATT_PROBE
template <int KIND> __global__ void __launch_bounds__(NTHREADS) att_probe(Params p) {
    extern __shared__ __attribute__((aligned(16))) unsigned char lds_raw[];
    att::attn_unit<KIND>(p, 0, (LAS unsigned char*)lds_raw, blockIdx.x & 7, blockIdx.x >> 3);
}
template __global__ void att_probe<0>(Params);
template __global__ void att_probe<1>(Params);
template __global__ void att_probe<2>(Params);
#endif
```

```cpp
#include <hip/hip_runtime.h>
#include <hip/hip_cooperative_groups.h>
#include <cstdint>
#include <cstdio>
namespace cg = cooperative_groups;

#ifndef USE_FAST_ATTN
#define USE_FAST_ATTN 1
#endif
#ifndef USE_FAST_GEMM
#define USE_FAST_GEMM 1
#endif
#ifndef MK_MULTI
#define MK_MULTI 0
#endif

#define LAS __attribute__((address_space(3)))
typedef unsigned short bf16_t;
typedef short bf16x8 __attribute__((ext_vector_type(8)));
typedef float f32x4 __attribute__((ext_vector_type(4)));
typedef float f32x2 __attribute__((ext_vector_type(2)));
typedef unsigned u32x4 __attribute__((ext_vector_type(4)));
typedef unsigned u32x2 __attribute__((ext_vector_type(2)));
typedef __bf16 bf16x2_t __attribute__((ext_vector_type(2)));

constexpr int T_TOK = 16384, DM = 1024, SEQ = 2048, NBATCH = 8, FF = 3584, NE = 8;
constexpr int NIN = 2560;
constexpr int W_IN_LD = 2308;
constexpr float RMS_EPS = 1e-5f;
constexpr float LOG2E = 1.4426950408889634f;
constexpr float QSCALE = 0.125f * LOG2E;
constexpr int NWAVES = 8, NTHREADS = 512;

constexpr size_t MiB = 1u << 20;
constexpr size_t OFF_CTL = 0;
constexpr size_t CTL_BYTES = 32768;
constexpr size_t OFF_ROPE = 1 * MiB;
constexpr size_t OFF_SSQA = 2 * MiB;
constexpr size_t OFF_SSQB = 3 * MiB;
constexpr size_t OFF_LOGF = 4 * MiB;
constexpr size_t OFF_CW = 4 * MiB + 256 * 1024;
constexpr size_t OFF_CT = 4 * MiB + 512 * 1024;
constexpr size_t OFF_KMEAN = 4 * MiB + 768 * 1024;
constexpr size_t OFF_TOKE = 5 * MiB;
constexpr size_t OFF_TOKP = 5 * MiB + 128 * 1024;
constexpr size_t OFF_TOKG = 5 * MiB + 256 * 1024;
constexpr size_t OFF_IDX = 6 * MiB;
constexpr size_t OFF_WRT = 6 * MiB + 512 * 1024;
constexpr size_t OFF_PLOG = 244 * MiB;
constexpr size_t OFF_RSE = 7 * MiB;
constexpr size_t OFF_MGU = 8 * MiB;
constexpr size_t OFF_MDN = 120 * MiB;
constexpr size_t OFF_HB = 176 * MiB;
constexpr size_t OFF_WIN = 208 * MiB;
constexpr size_t OFF_WOUT = 218 * MiB;
constexpr size_t OFF_DGU = 222 * MiB;
constexpr size_t OFF_DDN = 236 * MiB;
constexpr size_t OFF_Q = 244 * MiB;
constexpr size_t OFF_K = 276 * MiB;
constexpr size_t OFF_VT = 296 * MiB;
constexpr size_t OFF_Y = 316 * MiB;
constexpr size_t OFF_DACT = 244 * MiB;
constexpr size_t OFF_MACT = 208 * MiB;
constexpr size_t OFF_YBUF = 8 * MiB;
constexpr size_t WS_NEED = 448 * MiB;

constexpr int LDS_BYTES = 163840;

struct Params {
    const float* in[16];
    float* out;
    unsigned char* ws;
    int ph_lo, ph_hi;
};

__device__ __forceinline__ unsigned pk2(float lo, float hi) { f32x2 v = {lo, hi}; bf16x2_t b = __builtin_convertvector(v, bf16x2_t); return __builtin_bit_cast(unsigned, b); }
__device__ __forceinline__ unsigned short f2bf(float f) { return (unsigned short)(pk2(f, 0.f) & 0xffffu); }
__device__ __forceinline__ float bf2f(unsigned short b) { return __uint_as_float(((unsigned)b) << 16); }
__device__ __forceinline__ float bflo(unsigned w) { return __uint_as_float(w << 16); }
__device__ __forceinline__ float bfhi(unsigned w) { return __uint_as_float(w & 0xffff0000u); }
__device__ __forceinline__ float dpp_f(float v, const int ctrl_sel) {
    const int x = __builtin_bit_cast(int, v);
    int r;
    if (ctrl_sel == 0) r = __builtin_amdgcn_mov_dpp(x, 0xB1, 0xf, 0xf, true);
    else if (ctrl_sel == 1) r = __builtin_amdgcn_mov_dpp(x, 0x4E, 0xf, 0xf, true);
    else if (ctrl_sel == 2) r = __builtin_amdgcn_mov_dpp(x, 0x141, 0xf, 0xf, true);
    else r = __builtin_amdgcn_mov_dpp(x, 0x140, 0xf, 0xf, true);
    return __builtin_bit_cast(float, r);
}
__device__ __forceinline__ float wave_sum(float v) {
    v += dpp_f(v, 0); v += dpp_f(v, 1); v += dpp_f(v, 2); v += dpp_f(v, 3);
    { auto r = __builtin_amdgcn_permlane16_swap(__float_as_uint(v), __float_as_uint(v), false, false); v = __uint_as_float(r[0]) + __uint_as_float(r[1]); }
    { auto r = __builtin_amdgcn_permlane32_swap(__float_as_uint(v), __float_as_uint(v), false, false); v = __uint_as_float(r[0]) + __uint_as_float(r[1]); }
    return v;
}
__device__ __forceinline__ int phys32(int r) { return 16 * ((r >> 2) & 1) + 4 * (r >> 3) + (r & 3); }

__device__ __forceinline__ void tr_item(const float* __restrict__ W, int ld, int K, int nblk, const float* __restrict__ gs, bf16_t* __restrict__ Wt,
                                        int mapkind, int bj, int srcshift1536, LAS float* scr, int item, int lane) {
    const int kb = item / nblk, nb = item % nblk, k0 = 64 * kb, c0 = 32 * nb;
    const int srcc0 = (srcshift1536 && c0 >= 1536) ? c0 + 4 : c0;
    float vv[32];
#pragma unroll
    for (int i = 0; i < 32; ++i) vv[i] = __builtin_nontemporal_load(W + (size_t)(k0 + 2 * i + (lane >> 5)) * ld + srcc0 + (lane & 31));
    if (gs) {
#pragma unroll
        for (int i = 0; i < 32; ++i) vv[i] *= gs[k0 + 2 * i + (lane >> 5)];
    }
#pragma unroll
    for (int i = 0; i < 32; ++i) scr[(2 * i + (lane >> 5)) * 33 + (lane & 31)] = vv[i];
    asm volatile("s_waitcnt lgkmcnt(0)" ::: "memory");
    const int c = lane & 7;
#pragma unroll
    for (int j = 0; j < 4; ++j) {
        const int n = (lane >> 3) + 8 * j;
        int P;
        if (mapkind == 0) P = (c0 & ~32) | (n & 15) | ((n & 16) << 1) | ((c0 & 32) >> 1);
        else if (mapkind == 1) P = c0 + phys32(n);
        else P = (c0 >> 7) * 256 + 128 * bj + (c0 & 96) + phys32(n);
        const LAS float* s = scr + (8 * c) * 33 + n;
        u32x4 o; o.x = pk2(s[0 * 33], s[1 * 33]); o.y = pk2(s[2 * 33], s[3 * 33]); o.z = pk2(s[4 * 33], s[5 * 33]); o.w = pk2(s[6 * 33], s[7 * 33]);
        *(u32x4*)(Wt + (size_t)P * K + k0 + 8 * c) = o;
    }
    asm volatile("s_waitcnt lgkmcnt(0)" ::: "memory");
}

constexpr int I_IN = 16 * 72, I_OUT = 16 * 32, I_GU = 16 * 112, I_DN = 56 * 32;
constexpr int NITEMS_EARLY = 2 * I_IN + 2 * I_OUT + 2 * I_GU + I_DN;
constexpr int MOE_KM1_ITEMS = 4096;
constexpr int NITEMS_MOE = 8 * I_DN + 16 * I_GU;
__device__ __forceinline__ void conv_item(const Params& p, LAS float* scr, int it, int lane) {
    unsigned char* ws = p.ws;
    int r = it;
    if (r < 2 * I_IN) { const int l = r / I_IN; r %= I_IN;
        tr_item(p.in[2] + (size_t)l * DM * W_IN_LD, W_IN_LD, DM, 72, p.in[1] + l * DM, (bf16_t*)(ws + OFF_WIN) + (size_t)l * NIN * DM, 0, 0, 1, scr, r, lane); return; }
    r -= 2 * I_IN;
    if (r < 2 * I_OUT) { const int l = r / I_OUT; r %= I_OUT;
        tr_item(p.in[6] + (size_t)l * DM * DM, DM, DM, 32, p.in[5] + l * DM, (bf16_t*)(ws + OFF_WOUT) + (size_t)l * DM * DM, 1, 0, 0, scr, r, lane); return; }
    r -= 2 * I_OUT;
    if (r < 2 * I_GU) { const int bj = r / I_GU; r %= I_GU;
        tr_item(bj ? p.in[9] : p.in[8], FF, DM, 112, p.in[7], (bf16_t*)(ws + OFF_DGU), 2, bj, 0, scr, r, lane); return; }
    r -= 2 * I_GU;
    if (r < I_DN) { tr_item(p.in[10], DM, FF, 32, nullptr, (bf16_t*)(ws + OFF_DDN), 1, 0, 0, scr, r, lane); return; }
    r -= I_DN;
    if (r < 8 * I_DN) { const int e = r / I_DN; r %= I_DN;
        tr_item(p.in[14] + (size_t)e * FF * DM, DM, FF, 32, nullptr, (bf16_t*)(ws + OFF_MDN) + (size_t)e * DM * FF, 1, 0, 0, scr, r, lane); return; }
    r -= 8 * I_DN;
    { const int e = r / (2 * I_GU); r %= 2 * I_GU; const int bj = r / I_GU; r %= I_GU;
        tr_item((bj ? p.in[13] : p.in[12]) + (size_t)e * DM * FF, FF, DM, 112, p.in[7] + DM, (bf16_t*)(ws + OFF_MGU) + (size_t)e * 2 * FF * DM, 2, bj, 0, scr, r, lane); }
}
__device__ __forceinline__ void conv_range(const Params& p, LAS unsigned char* lds, int lo, int hi) {
    const int tid = threadIdx.x, lane = tid & 63, wave = tid >> 6;
    const int gw = blockIdx.x * NWAVES + wave, NGW = gridDim.x * NWAVES;
    LAS float* scr = (LAS float*)(lds + wave * 8704);
    for (int it = lo + gw; it < hi; it += NGW) conv_item(p, scr, it, lane);
}
__device__ __forceinline__ void phase_prologue(const Params& p, LAS unsigned char* lds) {
    const int tid = threadIdx.x, lane = tid & 63, wave = tid >> 6;
    const int gw = blockIdx.x * NWAVES + wave, NGW = gridDim.x * NWAVES;
    unsigned char* ws = p.ws;
    conv_range(p, lds, 0, I_IN);
    {
        const int gt = blockIdx.x * NTHREADS + tid, NG = gridDim.x * NTHREADS;
        for (int it = gt; it < 2 * 256 * 128; it += NG) {
            const int m = it / (256 * 128), rr = (it / 128) % 256, k0 = (it % 128) * 8;
            float v[8];
#pragma unroll
            for (int q = 0; q < 8; ++q) v[q] = 0.f;
            if (rr < 4) {
#pragma unroll
                for (int q = 0; q < 8; ++q) v[q] = p.in[2][(size_t)m * DM * W_IN_LD + (size_t)(k0 + q) * W_IN_LD + 1536 + rr] * p.in[1][m * DM + k0 + q]; }
            u32x4 o; o.x = pk2(v[0], v[1]); o.y = pk2(v[2], v[3]); o.z = pk2(v[4], v[5]); o.w = pk2(v[6], v[7]);
            *(u32x4*)((bf16_t*)(ws + OFF_WIN) + ((size_t)m * NIN + 2304 + rr) * DM + k0) = o;
        }
        float* wrf = (float*)(ws + OFF_WRT);
        for (int it = gt; it < 8 * DM; it += NG) { const int e = it >> 10, k = it & 1023; wrf[it] = p.in[11][(size_t)k * 8 + e] * p.in[7][DM + k]; }
    }
    {
        const float* x = p.in[0]; bf16_t* hb = (bf16_t*)(ws + OFF_HB); float* ssq = (float*)(ws + OFF_SSQA);
        for (int row = gw; row < T_TOK; row += NGW) {
            const f32x4* xr = (const f32x4*)(x + (size_t)row * DM) + lane;
            f32x4 v[4]; float s = 0.f;
#pragma unroll
            for (int j = 0; j < 4; ++j) { v[j] = xr[64 * j]; s += (v[j].x * v[j].x + v[j].y * v[j].y) + (v[j].z * v[j].z + v[j].w * v[j].w); }
            s = wave_sum(s);
            u32x2* o8 = (u32x2*)(hb + (size_t)row * DM) + lane;
#pragma unroll
            for (int j = 0; j < 4; ++j) { u32x2 w; w.x = pk2(v[j].x, v[j].y); w.y = pk2(v[j].z, v[j].w); o8[64 * j] = w; }
            if (lane < 16) ssq[(size_t)row * 16 + lane] = (lane == 0) ? s : 0.f;
        }
    }
    {
        float* cs = (float*)(ws + OFF_ROPE); float* sn = cs + SEQ * 32;
        for (int i = blockIdx.x * NTHREADS + tid; i < SEQ * 32; i += gridDim.x * NTHREADS) {
            const int t = i >> 5, f = i & 31;
            double inv = 1.0;
            for (int k = 0; k < f; ++k) inv *= 0.74989420933245582730;
            const float invf = (float)inv;
            const float angf = (float)t * invf;
            const double xa = (double)angf;
            const double n = __builtin_rint(xa * 0.63661977236758134308);
            const double rr = (xa - n * 1.5707963267948966192) - n * 6.123233995736766e-17;
            const double r2 = rr * rr;
            double sp = rr * (1.0 + r2 * (-1.0 / 6 + r2 * (1.0 / 120 + r2 * (-1.0 / 5040 + r2 * (1.0 / 362880 + r2 * (-1.0 / 39916800 + r2 * (1.0 / 6227020800.0)))))));
            double cp = 1.0 + r2 * (-0.5 + r2 * (1.0 / 24 + r2 * (-1.0 / 720 + r2 * (1.0 / 40320 + r2 * (-1.0 / 3628800 + r2 * (1.0 / 479001600.0 + r2 * (-1.0 / 87178291200.0)))))));
            const int q = ((int)n) & 3;
            double c, s;
            if (q == 0) { c = cp; s = sp; } else if (q == 1) { c = -sp; s = cp; } else if (q == 2) { c = -cp; s = -sp; } else { c = sp; s = -cp; }
            cs[i] = (float)c; sn[i] = (float)s;
        }
    }
}

struct Unit { int orow0, rows, brow0, pn; const int* gidx; int koff; const float* rsp; };

struct DenseSched {
    int nM, nN, nwg, G, c, full, rem, mode;
    __device__ void init(int M, int Nphys, int G_, int c_, int mode_ = 0) { nM = M / 256; nN = Nphys / 256; nwg = nM * nN; G = G_; c = c_; full = nwg / G; rem = nwg % G; mode = mode_;
        if (mode && !(rem > 0 && 2 * rem <= G)) mode = mode_ == 1 ? 0 : 3; }
    __device__ void tile(int L, int& pm, int& pn) const {
        int wgid = L; { const int q = nwg / 8, r = nwg % 8, xcd = wgid % 8, off = wgid / 8; wgid = (xcd < r ? xcd * (q + 1) : r * (q + 1) + (xcd - r) * q) + off; }
        const int nig = 8 * nN, gid = wgid / nig, fm = gid * 8, gsz = (nM - fm) < 8 ? (nM - fm) : 8;
        pm = fm + ((wgid % nig) % gsz); pn = (wgid % nig) / gsz;
    }
    __device__ bool next(int i, Unit& u) const {
        int pm, pn, half = -1;
        if (mode == 3) return false;
        if (mode == 2) { if (i > 0 || c >= 2 * rem) return false; tile(full * G + (c >> 1), pm, pn); half = c & 1; }
        else { const long L = (long)i * G + c; if (L >= (mode == 1 ? (long)full * G : (long)nwg)) return false; tile((int)L, pm, pn); }
        u.orow0 = pm * 256 + (half > 0 ? 128 : 0); u.rows = half >= 0 ? 128 : 256; u.brow0 = pn * 256; u.pn = pn; u.gidx = nullptr; u.koff = 0; u.rsp = nullptr; return true;
    }
};
struct MoeSched {
    int cnt[NE], base[NE], nrt[NE], total, nct, nphys, G, c, ksplit, khalf, mode, full, rem; const int* idx; const float* rse;
    bool gather;
    __device__ void init(const int* counts, const int* idx_, int nct_, int nphys_, int G_, int c_, bool gather_, int ksplit_ = 1, int khalf_ = 0, int mode_ = 0) {
        gather = gather_; ksplit = ksplit_; khalf = khalf_; rse = nullptr;
        int b = 0, tot = 0;
#pragma unroll
        for (int e = 0; e < NE; ++e) { cnt[e] = counts[e]; base[e] = b; b += cnt[e]; nrt[e] = (cnt[e] + 255) >> 8; tot += nrt[e] * nct_ * ksplit_; }
        total = tot; nct = nct_; nphys = nphys_; G = G_; c = c_; idx = idx_;
        full = total / G; rem = total % G; mode = mode_;
        if (mode && !(rem > 0 && 2 * rem <= G)) mode = mode_ == 1 ? 0 : 3;
    }
    __device__ bool next(int i, Unit& u) const {
        int half = -1; long L;
        if (mode == 3) return false;
        if (mode == 2) { if (i > 0 || c >= 2 * rem) return false; L = (long)full * G + (c >> 1); half = c & 1; }
        else { L = (long)i * G + c; if (L >= (mode == 1 ? (long)full * G : (long)total)) return false; }
        int l = (int)L, e = 0;
#pragma unroll
        for (int k = 0; k < NE; ++k) { const int n = nrt[k] * nct * ksplit; if (e == k && l >= n) { l -= n; e = k + 1; } }
        int nr = 1, bs = 0, cn = 0;
#pragma unroll
        for (int k = 0; k < NE; ++k) if (e == k) { nr = nrt[k]; bs = base[k]; cn = cnt[k]; }
        const int kh = l % ksplit; l /= ksplit;
        const int ctile = l / nr, rt = l % nr;
        int rows = min(256, cn - rt * 256), roff = 0;
        if (half >= 0) { if (half == 1 && rows > 128) { roff = 128; rows -= 128; } else rows = min(rows, 128); }
        u.orow0 = bs + rt * 256 + roff; u.rows = rows; u.brow0 = e * nphys + ctile * 256; u.pn = ctile + (kh << 8); u.koff = kh * khalf;
        u.gidx = gather ? idx + (size_t)e * T_TOK + rt * 256 + roff : nullptr; u.rsp = rse + (size_t)e * T_TOK + rt * 256 + roff; return true;
    }
};

__device__ __forceinline__ float rstd_from_ssq(const float* ssq, int tok) {
    const f32x4* q = (const f32x4*)(ssq + (size_t)tok * 16);
    const f32x4 a = q[0], b = q[1], c = q[2], d = q[3];
    const float s = ((a.x + a.y) + (a.z + a.w)) + ((b.x + b.y) + (b.z + b.w)) + ((c.x + c.y) + (c.z + c.w)) + ((d.x + d.y) + (d.z + d.w));
    return __builtin_amdgcn_rsqf(s * (1.0f / DM) + RMS_EPS);
}

struct EpiInProj {
    const float* ssq; const float* cosT; const float* sinT; bf16_t* Q; bf16_t* Kb; bf16_t* Vt; float* flog; const float* fbias;
    __device__ __forceinline__ void operator()(const f32x4 (&acc)[2][2][4][2], const Unit& u, int wr, int wc, int fr, int fq) const {
        const int hh = wc >> 1, g = wc & 1;
        int kind[2], col0[2];
#pragma unroll
        for (int bj = 0; bj < 2; ++bj) { const int hp = u.pn * 2 + bj; int k, c;
            if (hp < 4) { k = 0; c = hp * 128; } else if (hp == 4) { k = 1; c = 0; } else if (hp == 5) { k = 4; c = 0; }
            else if (hp < 8) { k = 2; c = 512 + (hp - 6) * 128; } else if (hp < 10) { k = 3; c = 128 + (hp - 8) * 128; } else if (hp < 12) { k = 4; c = 2 + (hp - 10) * 2; }
            else if (hp < 14) { k = 0; c = 768 + (hp - 12) * 128; } else if (hp < 16) { k = 1; c = 384 + (hp - 14) * 128; } else if (hp < 18) { k = 4; c = 6 + (hp - 16) * 2; }
            else if (hp == 18) { k = 5; c = 0; } else { k = 6; c = 0; }
            kind[bj] = k; col0[bj] = c; }
        const bool need_rope = kind[0] <= 1 || kind[1] <= 1;
#pragma unroll
        for (int ai = 0; ai < 2; ++ai) {
            if (128 * ai >= u.rows) continue;
#pragma unroll
            for (int m = 0; m < 4; ++m) {
                const int row = u.orow0 + 128 * ai + 64 * wr + 16 * m + fr;
                const float rs = rstd_from_ssq(ssq, row);
                const int t = row & (SEQ - 1), b = row >> 11;
                f32x4 cs = {0.f, 0.f, 0.f, 0.f}, sn = {0.f, 0.f, 0.f, 0.f};
                if (need_rope) { cs = *(const f32x4*)(cosT + t * 32 + 16 * g + 4 * fq); sn = *(const f32x4*)(sinT + t * 32 + 16 * g + 4 * fq); }
#pragma unroll
                for (int bj = 0; bj < 2; ++bj) {
                    const int kd = kind[bj];
                    if (kd == 6) continue;
                    if (kd == 5) { if (wc == 0 && fq == 0) { const f32x4 fb = *(const f32x4*)fbias; *(f32x4*)(flog + (size_t)row * 4) = acc[ai][bj][m][0] * rs + fb; } continue; }
                    const float sc = (kd == 0 || kd == 2) ? rs * QSCALE : rs;
                    f32x4 x1 = acc[ai][bj][m][0] * sc, x2 = acc[ai][bj][m][1] * sc;
                    if (kd <= 1) { const f32x4 o1 = x1 * cs - x2 * sn, o2 = x2 * cs + x1 * sn; x1 = o1; x2 = o2; }
                    if (kd == 4) {
                        const int tp = (t & ~15) | (((t >> 2) & 1) << 3) | (((t >> 3) & 1) << 2) | (t & 3);
                        const unsigned odd = fr & 1;
                        bf16_t* vb = Vt + ((size_t)(b * 10 + col0[bj] + hh) * 64 + 16 * g + 4 * fq + odd) * SEQ + (tp & ~1);
#pragma unroll
                        for (int hx = 0; hx < 2; ++hx) {
                            const f32x4 xx = hx ? x2 : x1;
                            const unsigned wa = pk2(xx[0], xx[1]), wb = pk2(xx[2], xx[3]);
                            const unsigned pa = (unsigned)__builtin_amdgcn_mov_dpp((int)wa, 0xB1, 0xf, 0xf, true), pb = (unsigned)__builtin_amdgcn_mov_dpp((int)wb, 0xB1, 0xf, 0xf, true);
                            const unsigned oa = odd ? ((pa >> 16) | (wa & 0xffff0000u)) : ((wa & 0xffffu) | (pa << 16)), ob = odd ? ((pb >> 16) | (wb & 0xffff0000u)) : ((wb & 0xffffu) | (pb << 16));
                            *(unsigned*)(vb + (size_t)(32 * hx) * SEQ) = oa; *(unsigned*)(vb + (size_t)(32 * hx + 2) * SEQ) = ob;
                        }
                    } else {
                        const unsigned w1x = pk2(x1[0], x1[1]), w1y = pk2(x1[2], x1[3]), w2x = pk2(x2[0], x2[1]), w2y = pk2(x2[2], x2[3]);
                        const auto sx = __builtin_amdgcn_permlane16_swap(w1x, w2x, false, false), sy = __builtin_amdgcn_permlane16_swap(w1y, w2y, false, false);
                        bf16_t* dst = ((kd == 0 || kd == 2) ? Q + (size_t)row * 1024 : Kb + (size_t)row * 640) + col0[bj] + hh * 64 + 16 * g + 4 * (fq & 2) + 32 * (fq & 1);
                        *(u32x4*)dst = (u32x4){sx[0], sy[0], sx[1], sy[1]};
                    }
                }
            }
        }
    }
};
template <bool ROUTER> struct EpiResid {
    bf16_t* hb; float* ssq; const float* wrf; float* plog;
    __device__ __forceinline__ void operator()(const f32x4 (&acc)[2][2][4][2], const Unit& u, int wr, int wc, int fr, int fq) const {
#pragma unroll
        for (int ai = 0; ai < 2; ++ai) {
            u32x4 pre[ROUTER ? 1 : 4][2];
            if (!ROUTER) {
#pragma unroll
                for (int m = 0; m < 4; ++m)
#pragma unroll
                    for (int bj = 0; bj < 2; ++bj) pre[ROUTER ? 0 : m][bj] = *(const u32x4*)(hb + (size_t)(u.orow0 + 128 * ai + 64 * wr + 16 * m + fr) * DM + u.pn * 256 + 128 * bj + 32 * wc + 8 * fq);
                asm volatile("" ::: "memory");
            }
#pragma unroll
            for (int m = 0; m < 4; ++m) {
                const int row = u.orow0 + 128 * ai + 64 * wr + 16 * m + fr;
                float ss = 0.f;
                f32x4 vv[2][2];
#pragma unroll
                for (int bj = 0; bj < 2; ++bj) {
                    const size_t off = (size_t)row * DM + u.pn * 256 + 128 * bj + 32 * wc + 8 * fq;
                    const u32x4 rw = ROUTER ? *(const u32x4*)(hb + off) : pre[ROUTER ? 0 : m][bj];
                    const f32x4 r0 = {bflo(rw.x), bfhi(rw.x), bflo(rw.y), bfhi(rw.y)}, r1 = {bflo(rw.z), bfhi(rw.z), bflo(rw.w), bfhi(rw.w)};
                    const f32x4 v0 = r0 + acc[ai][bj][m][0], v1 = r1 + acc[ai][bj][m][1];
                    u32x4 w; w.x = pk2(v0[0], v0[1]); w.y = pk2(v0[2], v0[3]); w.z = pk2(v1[0], v1[1]); w.w = pk2(v1[2], v1[3]);
                    *(u32x4*)(hb + off) = w;
                    ss += (v0[0] * v0[0] + v0[1] * v0[1]) + (v0[2] * v0[2] + v0[3] * v0[3]) + (v1[0] * v1[0] + v1[1] * v1[1]) + (v1[2] * v1[2] + v1[3] * v1[3]);
                    vv[bj][0] = v0; vv[bj][1] = v1;
                }
                ss += __shfl_xor(ss, 16); ss += __shfl_xor(ss, 32);
                if (fq == 0) ssq[(size_t)row * 16 + u.pn * 4 + wc] = ss;
                if (ROUTER) {
                    float pl[8];
#pragma unroll
                    for (int e = 0; e < 8; ++e) { float a = 0.f;
#pragma unroll
                        for (int bj = 0; bj < 2; ++bj) { const f32x4* wp = (const f32x4*)(wrf + e * DM + u.pn * 256 + 128 * bj + 32 * wc + 8 * fq); const f32x4 w0 = wp[0], w1 = wp[1];
                            a += (vv[bj][0][0] * w0[0] + vv[bj][0][1] * w0[1]) + (vv[bj][0][2] * w0[2] + vv[bj][0][3] * w0[3]) + (vv[bj][1][0] * w1[0] + vv[bj][1][1] * w1[1]) + (vv[bj][1][2] * w1[2] + vv[bj][1][3] * w1[3]); }
                        a += __shfl_xor(a, 16); a += __shfl_xor(a, 32); pl[e] = a; }
                    if (fq == 0) { f32x4* dp = (f32x4*)(plog + ((size_t)row * 16 + u.pn * 4 + wc) * 8); dp[0] = (f32x4){pl[0], pl[1], pl[2], pl[3]}; dp[1] = (f32x4){pl[4], pl[5], pl[6], pl[7]}; }
                }
            }
        }
    }
};
template <bool MOE> struct EpiSwiGLU {
    const float* ssq; bf16_t* act;
    __device__ __forceinline__ void operator()(const f32x4 (&acc)[2][2][4][2], const Unit& u, int wr, int wc, int fr, int fq) const {
        float rs[2][4];
#pragma unroll
        for (int ai = 0; ai < 2; ++ai)
#pragma unroll
            for (int m = 0; m < 4; ++m) {
                const int r = 128 * ai + 64 * wr + 16 * m + fr; const int rr = r < u.rows ? r : u.rows - 1;
                if (MOE) rs[ai][m] = u.rsp[rr]; else rs[ai][m] = rstd_from_ssq(ssq, u.orow0 + rr);
            }
#pragma unroll
        for (int ai = 0; ai < 2; ++ai) {
            float g[4][8], e[4][8];
#pragma unroll
            for (int m = 0; m < 4; ++m)
#pragma unroll
                for (int q = 0; q < 8; ++q) { g[m][q] = acc[ai][0][m][q >> 2][q & 3] * rs[ai][m]; e[m][q] = __builtin_amdgcn_exp2f(g[m][q] * (-LOG2E)); }
#pragma unroll
            for (int m = 0; m < 4; ++m)
#pragma unroll
                for (int q = 0; q < 8; ++q) e[m][q] = __builtin_amdgcn_rcpf(1.0f + e[m][q]);
#pragma unroll
            for (int m = 0; m < 4; ++m) {
                const int r = 128 * ai + 64 * wr + 16 * m + fr;
                float o[8];
#pragma unroll
                for (int q = 0; q < 8; ++q) o[q] = (g[m][q] * e[m][q]) * (acc[ai][1][m][q >> 2][q & 3] * rs[ai][m]);
                if (r < u.rows) { u32x4 w; w.x = pk2(o[0], o[1]); w.y = pk2(o[2], o[3]); w.z = pk2(o[4], o[5]); w.w = pk2(o[6], o[7]);
                    *(u32x4*)(act + (size_t)(u.orow0 + r) * FF + u.pn * 128 + 32 * wc + 8 * fq) = w; }
            }
        }
    }
};
struct EpiY {
    unsigned char* ws;
    __device__ __forceinline__ static bf16_t* yrow(unsigned char* ws_, int kh, int row) {
        if (kh == 0) return (bf16_t*)(ws_ + OFF_YBUF) + (size_t)row * DM;
        return row < 24576 ? (bf16_t*)(ws_ + 72 * MiB) + (size_t)row * DM : (bf16_t*)(ws_ + 432 * MiB) + (size_t)(row - 24576) * DM;
    }
    __device__ __forceinline__ void operator()(const f32x4 (&acc)[2][2][4][2], const Unit& u, int wr, int wc, int fr, int fq) const {
        const int kh = u.pn >> 8, pn = u.pn & 255;
#pragma unroll
        for (int ai = 0; ai < 2; ++ai)
#pragma unroll
            for (int m = 0; m < 4; ++m) {
                const int r = 128 * ai + 64 * wr + 16 * m + fr;
                if (r < u.rows) {
                    bf16_t* yr = yrow(ws, kh, u.orow0 + r);
#pragma unroll
                    for (int bj = 0; bj < 2; ++bj) { const f32x4 v0 = acc[ai][bj][m][0], v1 = acc[ai][bj][m][1];
                        u32x4 w; w.x = pk2(v0[0], v0[1]); w.y = pk2(v0[2], v0[3]); w.z = pk2(v1[0], v1[1]); w.w = pk2(v1[2], v1[3]);
                        *(u32x4*)(yr + pn * 256 + 128 * bj + 32 * wc + 8 * fq) = w; }
                }
            }
    }
};

template <class Epi, class Sched>
__device__ __forceinline__ void gemm_simple(const bf16_t* __restrict__ A, const bf16_t* __restrict__ Bt, int K, int Kloop, const Sched& S, const Epi& E) {
    const int tid = threadIdx.x, wid = tid >> 6, lane = tid & 63, wr = wid >> 2, wc = wid & 3, fr = lane & 15, fq = lane >> 4;
    Unit u;
    for (int i = 0; S.next(i, u); ++i) {
        f32x4 acc[2][2][4][2];
#pragma unroll
        for (int a = 0; a < 2; ++a)
#pragma unroll
            for (int b = 0; b < 2; ++b)
#pragma unroll
                for (int m = 0; m < 4; ++m)
#pragma unroll
                    for (int n = 0; n < 2; ++n) acc[a][b][m][n] = (f32x4){0.f, 0.f, 0.f, 0.f};
        const bf16_t* ar[2][4]; const bf16_t* br[2][2];
#pragma unroll
        for (int ai = 0; ai < 2; ++ai)
#pragma unroll
            for (int m = 0; m < 4; ++m) { int r = 128 * ai + 64 * wr + 16 * m + fr; if (r >= u.rows) r = u.rows - 1;
                const int src = u.gidx ? u.gidx[r] : u.orow0 + r; ar[ai][m] = A + (size_t)src * K + u.koff + 8 * fq; }
#pragma unroll
        for (int bj = 0; bj < 2; ++bj)
#pragma unroll
            for (int n = 0; n < 2; ++n) br[bj][n] = Bt + (size_t)(u.brow0 + 128 * bj + 32 * wc + 16 * n + fr) * K + u.koff + 8 * fq;
        for (int k0 = 0; k0 < Kloop; k0 += 32) {
            bf16x8 a[2][4], b[2][2];
#pragma unroll
            for (int ai = 0; ai < 2; ++ai)
#pragma unroll
                for (int m = 0; m < 4; ++m) a[ai][m] = *(const bf16x8*)(ar[ai][m] + k0);
#pragma unroll
            for (int bj = 0; bj < 2; ++bj)
#pragma unroll
                for (int n = 0; n < 2; ++n) b[bj][n] = *(const bf16x8*)(br[bj][n] + k0);
#pragma unroll
            for (int ai = 0; ai < 2; ++ai)
#pragma unroll
                for (int bj = 0; bj < 2; ++bj)
#pragma unroll
                    for (int m = 0; m < 4; ++m)
#pragma unroll
                        for (int n = 0; n < 2; ++n) acc[ai][bj][m][n] = __builtin_amdgcn_mfma_f32_16x16x32_bf16(b[bj][n], a[ai][m], acc[ai][bj][m][n], 0, 0, 0);
        }
        E(acc, u, wr, wc, fr, fq);
    }
}

namespace pg {
constexpr int BK = 64, HALF = 128, HTB = HALF * BK * 2, STAGE_BYTES = 8 * HTB;
__device__ __forceinline__ int lds_byte(int r, int c) { const int st = (r >> 4) * 2 + (c >> 5), rr = r & 15, cc = c & 31, ob = rr * 64 + cc * 2; return st * 1024 + (ob ^ (((ob >> 9) & 1) << 5)); }
__device__ __forceinline__ void stage_rc(int b, int& R, int& C) { const int st = b / 1024, sb = b % 1024, swz = sb ^ (((sb >> 9) & 1) << 5); R = (st >> 1) * 16 + swz / 64; C = (st & 1) * 32 + (swz % 64) / 2; }

template <bool HALFROWS, class Epi, class Sched>
__device__ __forceinline__ void gemm_fast(LAS unsigned char* lds, const bf16_t* A, const bf16_t* Bt, const int K, const int Kloop, const Sched& S, const Epi& E) {
    const int tid = threadIdx.x, wid = __builtin_amdgcn_readfirstlane(tid >> 6), lane = tid & 63, wr = wid >> 2, wc = wid & 3, fr = lane & 15, fq = lane >> 4;
    const int nt = Kloop / BK;
    int Rv[2], Cv[2];
    unsigned voffB[2];
#pragma unroll
    for (int i = 0; i < 2; ++i) { stage_rc(tid * 16 + i * 8192, Rv[i], Cv[i]); voffB[i] = (unsigned)(Rv[i] * K + Cv[i]) * 2u; }
    const size_t kstep = (size_t)(BK * 2);
    const size_t hstepB = (size_t)HALF * K * 2;
    const unsigned ldsw = (unsigned)wid * 1024u;
    const int aoff = lds_byte(wr * 64 + fr, fq * 8), boff = lds_byte(wc * 32 + fr, fq * 8);
#define PG_SA(b, h) (((b) * 2 + (h)) * HTB)
#define PG_SB(b, h) ((4 + (b) * 2 + (h)) * HTB)
#define PG_STAGE(bufoff, gbase, voff) do { _Pragma("unroll") for (int _i = 0; _i < 2; ++_i) \
        __builtin_amdgcn_global_load_lds((const unsigned*)((const char*)(gbase) + (voff)[_i]), (LAS unsigned*)(lds + (bufoff) + ldsw + _i * 8192), 16, 0, 0); } while (0)
#define PG_LDA(dst, b, h) do { _Pragma("unroll") for (int m = 0; m < 4; ++m) _Pragma("unroll") for (int k = 0; k < 2; ++k) dst[m][k] = *(const LAS bf16x8*)(lds + PG_SA(b, h) + aoff + m * 2048 + k * 1024); } while (0)
#define PG_LDB(dst, b, h) do { _Pragma("unroll") for (int n = 0; n < 2; ++n) _Pragma("unroll") for (int k = 0; k < 2; ++k) dst[n][k] = *(const LAS bf16x8*)(lds + PG_SB(b, h) + boff + n * 2048 + k * 1024); } while (0)
#define PG_MMA(ai, bj, At, Bf) do { __builtin_amdgcn_s_setprio(1); _Pragma("unroll") for (int m = 0; m < 4; ++m) _Pragma("unroll") for (int n = 0; n < 2; ++n) _Pragma("unroll") for (int k = 0; k < 2; ++k) \
        acc[ai][bj][m][n] = __builtin_amdgcn_mfma_f32_16x16x32_bf16(Bf[n][k], At[m][k], acc[ai][bj][m][n], 0, 0, 0); __builtin_amdgcn_s_setprio(0); } while (0)
#define PG_WAIT_V(n) asm volatile("s_waitcnt vmcnt(" #n ")" ::: "memory")
#define PG_WAIT_L(n) asm volatile("s_waitcnt lgkmcnt(" #n ")" ::: "memory")
#define PG_BAR __builtin_amdgcn_s_barrier()
#define PG_SCHED __builtin_amdgcn_sched_barrier(0)
#define PG_ALOAD(u, sr) do { _Pragma("unroll") for (int _i = 0; _i < 2; ++_i) { \
        int r0_ = Rv[_i], r1_ = 128 + Rv[_i]; if (r0_ >= (u).rows) r0_ = (u).rows - 1; if (r1_ >= (u).rows) r1_ = (u).rows - 1; \
        sr[2 * _i] = (u).gidx ? (u).gidx[r0_] : (u).orow0 + r0_; sr[2 * _i + 1] = (u).gidx ? (u).gidx[r1_] : (u).orow0 + r1_; } } while (0)
#define PG_AFIN(sr, a0, a1) do { _Pragma("unroll") for (int _i = 0; _i < 2; ++_i) { \
        a0[_i] = ((unsigned)sr[2 * _i] * (unsigned)K + (unsigned)Cv[_i]) * 2u; a1[_i] = ((unsigned)sr[2 * _i + 1] * (unsigned)K + (unsigned)Cv[_i]) * 2u; } } while (0)
    Unit cur, nxt, nn; int ui = 0;
    if (!S.next(0, cur)) return;
    f32x4 acc[2][2][4][2];
#pragma unroll
    for (int a = 0; a < 2; ++a)
#pragma unroll
        for (int b = 0; b < 2; ++b)
#pragma unroll
            for (int m = 0; m < 4; ++m)
#pragma unroll
                for (int n = 0; n < 2; ++n) acc[a][b][m][n] = (f32x4){0.f, 0.f, 0.f, 0.f};
    bf16x8 At[4][2], B0[2][2], B1[2][2];
    unsigned ca0[2], ca1[2], na0[2], na1[2];
    int sr[4];
    bool has_next = S.next(1, nxt);
    if (!has_next) nxt = cur;
    PG_ALOAD(cur, sr); PG_AFIN(sr, ca0, ca1);
    PG_ALOAD(nxt, sr); PG_AFIN(sr, na0, na1);
    const char* Ab = (const char*)A + (size_t)cur.koff * 2;
    const char* cB = (const char*)Bt + (size_t)cur.brow0 * K * 2 + (size_t)cur.koff * 2;
    PG_STAGE(PG_SB(0, 0), cB, voffB); PG_STAGE(PG_SB(0, 1), cB + hstepB, voffB); PG_STAGE(PG_SA(0, 0), Ab, ca0); PG_STAGE(PG_SA(0, 1), Ab, ca1);
    if (wr == 1) PG_BAR;
    PG_WAIT_V(2); PG_BAR;
    PG_STAGE(PG_SB(1, 0), cB + kstep, voffB); PG_STAGE(PG_SA(1, 0), Ab + kstep, ca0); PG_STAGE(PG_SB(1, 1), cB + hstepB + kstep, voffB);
    PG_WAIT_V(6); PG_BAR;
    for (;;) {
        bool has_nn = has_next && S.next(ui + 2, nn);
        if (!has_nn) nn = nxt;
        const char* nB = (const char*)Bt + (size_t)nxt.brow0 * K * 2 + (size_t)nxt.koff * 2;
        const char* nAb = (const char*)A + (size_t)nxt.koff * 2;
        for (int t = 0; t < nt; t += 2) {
            const bool last = (t == nt - 2);
            const char* a1p = Ab + (size_t)(t + 1) * kstep;
            const char* a2p = last ? nAb : Ab + (size_t)(t + 2) * kstep; const char* b2p = last ? nB : cB + (size_t)(t + 2) * kstep;
            const char* a3p = a2p + kstep; const char* b3p = b2p + kstep;
            unsigned s0[2], s1[2];
#pragma unroll
            for (int i = 0; i < 2; ++i) { s0[i] = last ? na0[i] : ca0[i]; s1[i] = last ? na1[i] : ca1[i]; }
            PG_LDB(B0, 0, 0); PG_LDB(B1, 0, 1); PG_SCHED; PG_LDA(At, 0, 0); PG_STAGE(PG_SA(1, 1), a1p, ca1);
            PG_WAIT_V(8); PG_WAIT_L(0); PG_BAR; PG_MMA(0, 0, At, B0); PG_MMA(0, 1, At, B1); PG_BAR; PG_SCHED;
            PG_LDA(At, 0, 1); PG_STAGE(PG_SB(0, 0), b2p, voffB); PG_STAGE(PG_SB(0, 1), b2p + hstepB, voffB); PG_STAGE(PG_SA(0, 0), a2p, s0);
            PG_WAIT_V(8); PG_WAIT_L(0); PG_BAR; if constexpr (!HALFROWS) { PG_MMA(1, 0, At, B0); PG_MMA(1, 1, At, B1); } PG_BAR; PG_SCHED;
            PG_LDB(B0, 1, 0); PG_LDB(B1, 1, 1); PG_SCHED; PG_LDA(At, 1, 0); PG_STAGE(PG_SA(0, 1), a2p, s1);
            PG_WAIT_V(8); PG_WAIT_L(0); PG_BAR; PG_MMA(0, 0, At, B0); PG_MMA(0, 1, At, B1); PG_BAR; PG_SCHED;
            PG_LDA(At, 1, 1); PG_STAGE(PG_SB(1, 0), b3p, voffB); PG_STAGE(PG_SB(1, 1), b3p + hstepB, voffB); PG_STAGE(PG_SA(1, 0), a3p, s0);
            PG_WAIT_V(8); PG_WAIT_L(0); PG_BAR; if constexpr (!HALFROWS) { PG_MMA(1, 0, At, B0); PG_MMA(1, 1, At, B1); } PG_BAR; PG_SCHED;
        }
        if (wr == 0) PG_BAR;
        PG_ALOAD(nn, sr);
        E(acc, cur, wr, wc, fr, fq);
        if (!has_next) break;
#pragma unroll
        for (int a = 0; a < 2; ++a)
#pragma unroll
            for (int b = 0; b < 2; ++b)
#pragma unroll
                for (int m = 0; m < 4; ++m)
#pragma unroll
                    for (int n = 0; n < 2; ++n) acc[a][b][m][n] = (f32x4){0.f, 0.f, 0.f, 0.f};
        cur = nxt; cB = nB; Ab = nAb; ++ui;
#pragma unroll
        for (int i = 0; i < 2; ++i) { ca0[i] = na0[i]; ca1[i] = na1[i]; }
        nxt = nn; has_next = has_nn;
        PG_AFIN(sr, na0, na1);
        if (wr == 1) PG_BAR;
    }
    PG_WAIT_V(0);
    PG_BAR;
#undef PG_SA
#undef PG_SB
#undef PG_STAGE
#undef PG_LDA
#undef PG_LDB
#undef PG_MMA
#undef PG_WAIT_V
#undef PG_WAIT_L
#undef PG_BAR
#undef PG_SCHED
#undef PG_ALOAD
#undef PG_AFIN
}
}

__device__ __forceinline__ void phase_kmean(const Params& p, LAS unsigned char* lds) {
    const int tid = threadIdx.x;
    const bf16_t* Kb = (const bf16_t*)(p.ws + OFF_K); float* km = (float*)(p.ws + OFF_KMEAN);
    LAS float* red = (LAS float*)lds;
    for (int unit = blockIdx.x; unit < NBATCH * 4 * 8; unit += gridDim.x) {
        const int b = unit >> 5, hm = (unit >> 3) & 3, blk = unit & 7;
        const int ch = tid & 7, rg = tid >> 3;
        const bf16_t* src = Kb + (size_t)(b * SEQ + blk * 256 + rg * 4) * 640 + 384 + hm * 64 + ch * 8;
        u32x4 w[4];
#pragma unroll
        for (int i = 0; i < 4; ++i) w[i] = *(const u32x4*)(src + (size_t)i * 640);
        float sacc[8];
#pragma unroll
        for (int q = 0; q < 8; ++q) sacc[q] = 0.f;
#pragma unroll
        for (int i = 0; i < 4; ++i) { sacc[0] += bflo(w[i].x); sacc[1] += bfhi(w[i].x); sacc[2] += bflo(w[i].y); sacc[3] += bfhi(w[i].y);
            sacc[4] += bflo(w[i].z); sacc[5] += bfhi(w[i].z); sacc[6] += bflo(w[i].w); sacc[7] += bfhi(w[i].w); }
        LAS f32x4* rp = (LAS f32x4*)(red + rg * 64 + ch * 8);
        rp[0] = (f32x4){sacc[0], sacc[1], sacc[2], sacc[3]}; rp[1] = (f32x4){sacc[4], sacc[5], sacc[6], sacc[7]};
        __syncthreads();
        if (tid < 64) { float t = 0.f;
#pragma unroll 8
            for (int q = 0; q < 64; ++q) t += red[q * 64 + tid];
            km[(size_t)unit * 64 + tid] = t * (1.0f / 256.0f); }
        __syncthreads();
    }
}

__device__ __forceinline__ void phase_scan(const Params& p, LAS unsigned char* lds) {
    const int tid = threadIdx.x, lane = tid & 63, wave = tid >> 6;
    const float* flog = (const float*)(p.ws + OFF_LOGF); float* cw = (float*)(p.ws + OFF_CW);
    LAS float* wtot = (LAS float*)(lds + 4096);
    for (int unit = blockIdx.x; unit < NBATCH * 4; unit += gridDim.x) {
        const int b = unit >> 2, h = unit & 3;
        float v[4]; float run = 0.f;
#pragma unroll
        for (int q = 0; q < 4; ++q) { const float xv = flog[(size_t)(b * SEQ + 4 * tid + q) * 4 + h];
            const float ls = fminf(xv, 0.f) - 0.6931471805599453f * __builtin_amdgcn_logf(1.0f + __builtin_amdgcn_exp2f(-fabsf(xv) * LOG2E));
            run += ls; v[q] = run; }
        float inc = run;
#pragma unroll
        for (int o = 1; o < 64; o <<= 1) { const float t = __shfl_up(inc, o); if (lane >= o) inc += t; }
        if (lane == 63) wtot[wave] = inc;
        __syncthreads();
        float woff = 0.f;
#pragma unroll
        for (int w = 0; w < 8; ++w) { const float t = wtot[w]; if (w < wave) woff += t; }
        const float base = woff + (inc - run);
        f32x4 o; o.x = (base + v[0]) * LOG2E; o.y = (base + v[1]) * LOG2E; o.z = (base + v[2]) * LOG2E; o.w = (base + v[3]) * LOG2E;
        *(f32x4*)(cw + (size_t)unit * SEQ + 4 * tid) = o;
        __syncthreads();
    }
}

template <int KIND>
__device__ __forceinline__ void naive_attn_token(const Params& p, int layer, int row, int lane) {
    const bf16_t* Q = (const bf16_t*)(p.ws + OFF_Q); const bf16_t* Kb = (const bf16_t*)(p.ws + OFF_K); const bf16_t* Vt = (const bf16_t*)(p.ws + OFF_VT);
    bf16_t* Y = (bf16_t*)(p.ws + OFF_Y);
    const int b = row >> 11, t = row & (SEQ - 1);
    constexpr int NH = KIND == 0 ? 8 : 4;
    constexpr int QC0 = KIND == 0 ? 0 : (KIND == 1 ? 512 : 768);
    constexpr int KC0 = KIND == 0 ? 0 : (KIND == 1 ? 128 : 384);
    constexpr int VH0 = KIND == 0 ? 0 : (KIND == 1 ? 2 : 6);
    float sstot = 0.f;
    const int own = t >> 8;
    for (int h = 0; h < NH; ++h) {
        const int kvh = KIND == 0 ? (h >> 2) : h;
        const float qv = bf2f(Q[(size_t)row * 1024 + QC0 + h * 64 + lane]);
        unsigned selmask = 0;
        if (KIND == 2) {
            const float* km = (const float*)(p.ws + OFF_KMEAN) + (size_t)(b * 4 + h) * 8 * 64;
            float gsc[8];
#pragma unroll
            for (int j = 0; j < 8; ++j) gsc[j] = wave_sum(qv * km[j * 64 + lane]);
            const int nsel = own < 3 ? own : 3;
            for (int r = 0; r < nsel; ++r) { float best = -3.0e38f; int bi = 0;
#pragma unroll
                for (int j = 0; j < 8; ++j) { const bool ok = (j < own) && !((selmask >> j) & 1u); if (ok && gsc[j] > best) { best = gsc[j]; bi = j; } }
                selmask |= 1u << bi; }
        }
        float ctq = 0.f;
        const float* cwp = (const float*)(p.ws + OFF_CW) + (size_t)(b * 4 + h) * SEQ;
        if (KIND == 1) ctq = cwp[t];
        float mx = -1e30f, l = 0.f, oacc = 0.f;
        const int lo = KIND == 0 ? (t - 127 > 0 ? t - 127 : 0) : 0;
        const bf16_t* kbase = Kb + (size_t)(b * SEQ) * 640 + KC0 + kvh * 64;
        const bf16_t* vbase = Vt + (size_t)(b * 10 + VH0 + kvh) * 64 * SEQ;
        for (int s0 = lo & ~63; s0 <= t; s0 += 64) {
            if (KIND == 2) { const int blk = s0 >> 8; if (blk != own && !((selmask >> blk) & 1u)) continue; }
            const int s = s0 + lane;
            const u32x4* kp = (const u32x4*)(kbase + (size_t)s * 640);
            float a = 0.f;
#pragma unroll
            for (int c = 0; c < 8; ++c) { const u32x4 w = kp[c];
                a += __shfl(qv, 8 * c + 0) * bflo(w.x) + __shfl(qv, 8 * c + 1) * bfhi(w.x) + __shfl(qv, 8 * c + 2) * bflo(w.y) + __shfl(qv, 8 * c + 3) * bfhi(w.y)
                   + __shfl(qv, 8 * c + 4) * bflo(w.z) + __shfl(qv, 8 * c + 5) * bfhi(w.z) + __shfl(qv, 8 * c + 6) * bflo(w.w) + __shfl(qv, 8 * c + 7) * bfhi(w.w); }
            if (KIND == 1) a += ctq - cwp[s];
            const bool ok = (s <= t) && (s >= lo);
            float cm = ok ? a : -1e30f;
#pragma unroll
            for (int o = 1; o < 64; o <<= 1) cm = fmaxf(cm, __shfl_xor(cm, o));
            const float mnew = fmaxf(mx, cm);
            const float alpha = exp2f(mx - mnew);
            const float pj = ok ? exp2f(a - mnew) : 0.f;
            l = l * alpha + wave_sum(pj); mx = mnew;
            oacc *= alpha;
            const unsigned short pb = f2bf(pj);
            const float pjr = bf2f(pb);
            for (int d = 0; d < 64; ++d) { const float v = bf2f(vbase[(size_t)d * SEQ + s]); const float x = wave_sum(pjr * v); if (lane == d) oacc += x; }
        }
        if (KIND == 0) { const float sk = p.in[4][layer * 8 + h] * LOG2E; l += exp2f(sk - mx); }
        const float ov = oacc / l;
        sstot += wave_sum(ov * ov);
        Y[(size_t)row * 1024 + QC0 + h * 64 + lane] = f2bf(ov);
    }
    const float scale = 1.0f / sqrtf(sstot / (float)(NH * 64) + RMS_EPS);
    for (int h = 0; h < NH; ++h) { bf16_t* yp = Y + (size_t)row * 1024 + QC0 + h * 64 + lane; *yp = f2bf(bf2f(*yp) * scale); }
}
__device__ __forceinline__ void phase_attn_naive(const Params& p, int layer) {
    const int tid = threadIdx.x, lane = tid & 63, wave = tid >> 6;
    const int gw = blockIdx.x * NWAVES + wave, NGW = gridDim.x * NWAVES;
    for (int it = gw; it < 3 * T_TOK; it += NGW) {
        const int kind = it / T_TOK, row = it % T_TOK;
        if (kind == 0) naive_attn_token<0>(p, layer, row, lane); else if (kind == 1) naive_attn_token<1>(p, layer, row, lane); else naive_attn_token<2>(p, layer, row, lane);
    }
}

namespace att {
typedef float f32x16 __attribute__((ext_vector_type(16)));
constexpr int KT = 8192, VT = 8192;
constexpr int STAGE = 4 * (KT + VT);
constexpr int OFF_CK = 2 * STAGE;
constexpr int OFF_TAB = OFF_CK + 2 * 4 * 64 * 4;
constexpr int OFF_KM = OFF_TAB + 64 * 8 * 4;
constexpr int LDS_NEED = OFF_KM + 4 * 8 * 64 * 4;
constexpr float NEG = -1e30f, MINIT = -1e20f;
__device__ __forceinline__ int crow(int r, int h) { return (r & 3) + 8 * (r >> 2) + 4 * h; }
__device__ __forceinline__ float pswap_max(float v) { auto r = __builtin_amdgcn_permlane32_swap(__float_as_uint(v), __float_as_uint(v), false, false); return fmaxf(__uint_as_float(r[0]), __uint_as_float(r[1])); }
__device__ __forceinline__ float pswap_sum(float v) { auto r = __builtin_amdgcn_permlane32_swap(__float_as_uint(v), __float_as_uint(v), false, false); return __uint_as_float(r[0]) + __uint_as_float(r[1]); }

template <int KIND>
__device__ __forceinline__ void attn_unit(const Params& p, int layer, LAS unsigned char* lds, int b, int qt) {
    constexpr int NKV = KIND == 0 ? 2 : 4;
    constexpr int NRB = 1;
    constexpr int QR = KIND == 0 ? 32 : 64;
    constexpr int NH = KIND == 0 ? 8 : 4;
    constexpr int QC0 = KIND == 0 ? 0 : (KIND == 1 ? 512 : 768);
    constexpr int KC0 = KIND == 0 ? 0 : (KIND == 1 ? 128 : 384);
    constexpr int VH0 = KIND == 0 ? 0 : (KIND == 1 ? 2 : 6);
    constexpr int NCH = NKV * 512 / NTHREADS;
    const bf16_t* Q = (const bf16_t*)(p.ws + OFF_Q); const bf16_t* Kb = (const bf16_t*)(p.ws + OFF_K); const bf16_t* Vt = (const bf16_t*)(p.ws + OFF_VT);
    bf16_t* Y = (bf16_t*)(p.ws + OFF_Y);
    const float* cwg = (const float*)(p.ws + OFF_CW);
    const int tid = threadIdx.x, lane = tid & 63, wave = __builtin_amdgcn_readfirstlane(tid >> 6), r = lane & 31, h = lane >> 5;
    const int head = KIND == 0 ? wave : (wave >> 1);
    const int kvh = KIND == 0 ? (wave >> 2) : head;
    const int rb0 = KIND == 0 ? 0 : (wave & 1);
    const int q0 = qt * QR;
    const int own = q0 >> 8;
    const int jlo = KIND == 0 ? (q0 >= 127 ? (q0 - 127) >> 6 : 0) : 0;
    const int nt = ((q0 + QR - 1) >> 6) - jlo + 1;
    LAS float* ckb = (LAS float*)(lds + OFF_CK);
    LAS float* tab = (LAS float*)(lds + OFF_TAB);
    LAS float* kmt = (LAS float*)(lds + OFF_KM);

    constexpr int NDMA = NKV * 16 / 8;
    auto dma_tile = [&](int j, int st) {
        const int s0 = (jlo + j) * 64;
#pragma unroll
        for (int q = 0; q < NDMA / 2; ++q) {
            const int id = wave * (NDMA / 2) + q;
            const int hd = id >> 3, i8 = id & 7;
            const int row = 8 * i8 + (lane >> 3), c = (lane & 7) ^ ((row >> 1) & 7);
            __builtin_amdgcn_global_load_lds((const unsigned*)(Kb + ((size_t)b * SEQ + s0 + row) * 640 + KC0 + hd * 64 + c * 8), (LAS unsigned*)(lds + st * STAGE + hd * 8192 + i8 * 1024), 16, 0, 0);
            __builtin_amdgcn_global_load_lds((const unsigned*)(Vt + ((size_t)(b * 10 + VH0 + hd) * 64 + row) * SEQ + s0 + c * 8), (LAS unsigned*)(lds + st * STAGE + 4 * KT + hd * 8192 + i8 * 1024), 16, 0, 0);
        }
        if (KIND == 1 && wave < 4) __builtin_amdgcn_global_load_lds((const unsigned*)(cwg + (size_t)(b * 4 + wave) * SEQ + s0 + lane), (LAS unsigned*)(ckb + st * 256 + wave * 64), 4, 0, 0);
    };
    dma_tile(0, 0);
    bf16x8 qf[NRB][4];
#pragma unroll
    for (int rb = 0; rb < NRB; ++rb) { const size_t row = (size_t)b * SEQ + q0 + 32 * (rb0 + rb) + r;
#pragma unroll
        for (int s4 = 0; s4 < 4; ++s4) qf[rb][s4] = *(const bf16x8*)(Q + row * 1024 + QC0 + head * 64 + 16 * s4 + 8 * h); }
    unsigned selmask = 0;
    if (KIND == 2 && own > 0) {
        const float* km = (const float*)(p.ws + OFF_KMEAN) + (size_t)b * 4 * 8 * 64;
        for (int i = tid; i < 4 * 8 * 64; i += NTHREADS) kmt[i] = km[i];
        __syncthreads();
        float g[8];
#pragma unroll
        for (int j = 0; j < 8; ++j) { float a = 0.f;
            if (j < own) {
#pragma unroll
                for (int s4 = 0; s4 < 4; ++s4) { const LAS f32x4* kp = (const LAS f32x4*)(kmt + (head * 8 + j) * 64 + 16 * s4 + 8 * h); const f32x4 k0 = kp[0], k1 = kp[1];
                    const bf16x8 qq = qf[0][s4];
                    a += bf2f((unsigned short)qq[0]) * k0.x + bf2f((unsigned short)qq[1]) * k0.y + bf2f((unsigned short)qq[2]) * k0.z + bf2f((unsigned short)qq[3]) * k0.w
                       + bf2f((unsigned short)qq[4]) * k1.x + bf2f((unsigned short)qq[5]) * k1.y + bf2f((unsigned short)qq[6]) * k1.z + bf2f((unsigned short)qq[7]) * k1.w; } }
            g[j] = pswap_sum(a); }
        const int nsel = own < 3 ? own : 3;
        for (int rr = 0; rr < nsel; ++rr) { float best = -3.0e38f; int bi = 0;
#pragma unroll
            for (int j = 0; j < 8; ++j) { const bool ok = (j < own) && !((selmask >> j) & 1u); if (ok && g[j] > best) { best = g[j]; bi = j; } }
            selmask |= 1u << bi; }
    }

    float mrun[NRB], lrun[NRB]; f32x16 o[NRB][2];
#pragma unroll
    for (int rb = 0; rb < NRB; ++rb) { mrun[rb] = 0.f; lrun[rb] = 0.f;
#pragma unroll
        for (int d = 0; d < 2; ++d)
#pragma unroll
            for (int e = 0; e < 16; ++e) o[rb][d][e] = 0.f; }

    asm volatile("s_waitcnt vmcnt(0)" ::: "memory");
    __syncthreads();
    auto tile = [&](const LAS unsigned char* kst, const LAS unsigned char* vst, const LAS float* ckt, int s0, bool bnd, float lane_bias) {
        constexpr int rb = 0;
        const int t = q0 + 32 * rb0 + r;
        const float ainit = -mrun[rb];
        f32x16 S[2];
#pragma unroll
        for (int kb = 0; kb < 2; ++kb) { f32x16 a;
#pragma unroll
            for (int e = 0; e < 16; ++e) a[e] = ainit;
#pragma unroll
            for (int s4 = 0; s4 < 4; ++s4) { const int kr = 32 * kb + r; const bf16x8 kf = *(const LAS bf16x8*)(kst + kr * 128 + (((2 * s4 + h) ^ ((kr >> 1) & 7)) << 4));
                a = __builtin_amdgcn_mfma_f32_32x32x16_bf16(kf, qf[rb][s4], a, 0, 0, 0); }
            S[kb] = a; }
        if (KIND == 1) {
#pragma unroll
            for (int kb = 0; kb < 2; ++kb)
#pragma unroll
                for (int g4 = 0; g4 < 4; ++g4) { const f32x4 ckv = *(const LAS f32x4*)(ckt + 32 * kb + 8 * g4 + 4 * h);
#pragma unroll
                    for (int e = 0; e < 4; ++e) S[kb][4 * g4 + e] -= ckv[e]; }
        }
        if (KIND == 2 && __any(lane_bias != 0.f)) {
#pragma unroll
            for (int kb = 0; kb < 2; ++kb)
#pragma unroll
                for (int e = 0; e < 16; ++e) S[kb][e] += lane_bias;
        }
        if (bnd) {
#pragma unroll
            for (int kb = 0; kb < 2; ++kb)
#pragma unroll
                for (int reg = 0; reg < 16; ++reg) { const int key = s0 + 32 * kb + crow(reg, h);
                    const bool ok = (KIND == 0) ? ((key <= t) && (t - key < 128)) : (key <= t);
                    S[kb][reg] = ok ? S[kb][reg] : NEG; }
        }
        float mx = S[0][0];
#pragma unroll
        for (int e = 1; e < 16; ++e) mx = fmaxf(mx, S[0][e]);
#pragma unroll
        for (int e = 0; e < 16; ++e) mx = fmaxf(mx, S[1][e]);
        mx = pswap_max(mx);
        const bool mv = (mx > 8.0f) || (lrun[rb] == 0.f && mx < -8.0f && mx > -1e29f);
        if (__any(mv)) {
            const float delta = mv ? mx : 0.f;
            const float alpha = lrun[rb] == 0.f ? 1.0f : __builtin_amdgcn_exp2f(-delta);
            lrun[rb] *= alpha;
#pragma unroll
            for (int d = 0; d < 2; ++d)
#pragma unroll
                for (int e = 0; e < 16; ++e) o[rb][d][e] *= alpha;
            mrun[rb] += delta;
#pragma unroll
            for (int kb = 0; kb < 2; ++kb)
#pragma unroll
                for (int e = 0; e < 16; ++e) S[kb][e] -= delta;
        }
        float ps = 0.f;
#pragma unroll
        for (int kb = 0; kb < 2; ++kb)
#pragma unroll
            for (int e = 0; e < 16; ++e) { const float pv = __builtin_amdgcn_exp2f(S[kb][e]); S[kb][e] = pv; ps += pv; }
        lrun[rb] += ps;
        bf16x8 pb[2][2];
#pragma unroll
        for (int kb = 0; kb < 2; ++kb)
#pragma unroll
            for (int s2 = 0; s2 < 2; ++s2) { u32x4 w; w.x = pk2(S[kb][8 * s2 + 0], S[kb][8 * s2 + 1]); w.y = pk2(S[kb][8 * s2 + 2], S[kb][8 * s2 + 3]);
                w.z = pk2(S[kb][8 * s2 + 4], S[kb][8 * s2 + 5]); w.w = pk2(S[kb][8 * s2 + 6], S[kb][8 * s2 + 7]); pb[kb][s2] = __builtin_bit_cast(bf16x8, w); }
#pragma unroll
        for (int d = 0; d < 2; ++d)
#pragma unroll
            for (int kb = 0; kb < 2; ++kb)
#pragma unroll
                for (int s2 = 0; s2 < 2; ++s2) { const int dr = 32 * d + r, sw = (dr >> 1) & 7, c0 = 4 * kb + 2 * s2 + h;
                    const u32x4 vv = *(const LAS u32x4*)(vst + dr * 128 + ((c0 ^ sw) << 4));
                    o[rb][d] = __builtin_amdgcn_mfma_f32_32x32x16_bf16(__builtin_bit_cast(bf16x8, vv), pb[kb][s2], o[rb][d], 0, 0, 0); }
    };
    for (int j = 0; j < nt; ++j) {
        if (j + 1 < nt) dma_tile(j + 1, (j + 1) & 1);
        const int st = j & 1, s0 = (jlo + j) * 64;
        const LAS unsigned char* kst = lds + st * STAGE + kvh * KT;
        const LAS unsigned char* vst = lds + st * STAGE + 4 * KT + kvh * VT;
        const LAS float* ckt = ckb + st * 256 + kvh * 64;
        const bool moba_past = (KIND == 2) && ((s0 >> 8) != own);
        const bool lane_sel = (KIND == 2 && moba_past) ? (((selmask >> (s0 >> 8)) & 1u) != 0u) : true;
        bool bnd;
        if (KIND == 0) bnd = !((s0 + 63 <= q0) && (s0 >= q0 + 31 - 127));
        else bnd = (s0 + 63 > q0 + 32 * rb0);
        if (!(moba_past && !__any(lane_sel))) tile(kst, vst, ckt, s0, bnd, lane_sel ? 0.f : NEG);
        asm volatile("s_waitcnt vmcnt(0)" ::: "memory");
        __syncthreads();
    }
    float ssq_part[NRB];
#pragma unroll
    for (int rb = 0; rb < NRB; ++rb) {
        float l = pswap_sum(lrun[rb]);
        if (KIND == 0) l += __builtin_amdgcn_exp2f(p.in[4][layer * 8 + head] * LOG2E - mrun[rb]);
        const float inv = 1.0f / l; float ss = 0.f;
#pragma unroll
        for (int d = 0; d < 2; ++d)
#pragma unroll
            for (int e = 0; e < 16; ++e) { const float v = o[rb][d][e] * inv; o[rb][d][e] = v; ss += v * v; }
        ss = pswap_sum(ss); ssq_part[rb] = ss;
        if (h == 0) tab[(32 * (rb0 + rb) + r) * 8 + head] = ss;
    }
    __syncthreads();
#pragma unroll
    for (int rb = 0; rb < NRB; ++rb) {
        const int ql = 32 * (rb0 + rb) + r;
        float tot = 0.f;
#pragma unroll
        for (int hh = 0; hh < NH; ++hh) tot += tab[ql * 8 + hh];
        const float sc = 1.0f / sqrtf(tot * (1.0f / (NH * 64)) + RMS_EPS);
        bf16_t* yp = Y + ((size_t)b * SEQ + q0 + ql) * 1024 + QC0 + head * 64;
#pragma unroll
        for (int d = 0; d < 2; ++d)
#pragma unroll
            for (int g4 = 0; g4 < 4; ++g4) { u32x2 w; w.x = pk2(o[rb][d][4 * g4] * sc, o[rb][d][4 * g4 + 1] * sc); w.y = pk2(o[rb][d][4 * g4 + 2] * sc, o[rb][d][4 * g4 + 3] * sc);
                *(u32x2*)(yp + 32 * d + 8 * g4 + 4 * h) = w; }
    }
    (void)ssq_part;
    __syncthreads();
}

__device__ __forceinline__ void phase_attn(const Params& p, int layer, LAS unsigned char* lds) {
    for (int i = blockIdx.x; i < 256; i += gridDim.x) {
#pragma unroll 1
        for (int k = 0; k < 2; ++k) { const int j = k == 0 ? i : 511 - i; const int qt = 31 - (j >> 4), w = j & 15, b = w >> 1;
            if (w & 1) attn_unit<2>(p, layer, lds, b, qt); else attn_unit<1>(p, layer, lds, b, qt); }
        attn_unit<0>(p, layer, lds, i >> 5, 2 * (i & 31));
        attn_unit<0>(p, layer, lds, i >> 5, 2 * (i & 31) + 1);
    }
}
}

__device__ __forceinline__ void phase_top2(const Params& p, LAS unsigned char* lds) {
    const int tid = threadIdx.x, lane = tid & 63, wave = tid >> 6;
    const float* plog = (const float*)(p.ws + OFF_PLOG); const float* ssq = (const float*)(p.ws + OFF_SSQB);
    int* toke = (int*)(p.ws + OFF_TOKE); float* tokg = (float*)(p.ws + OFF_TOKG); int* ghist = (int*)(p.ws + OFF_CTL) + 16384;
    LAS int* hist = (LAS int*)lds;
    for (int k = blockIdx.x; k < T_TOK / 64; k += gridDim.x) {
        if (tid < 8) hist[tid] = 0;
        __syncthreads();
        int hc[8];
#pragma unroll
        for (int e = 0; e < 8; ++e) hc[e] = 0;
#pragma unroll
        for (int half = 0; half < 2; ++half) {
            f32x2 v[4]; float q[4];
#pragma unroll
            for (int u = 0; u < 4; ++u) { const int tok = 64 * k + 8 * wave + 4 * half + u;
                v[u] = *(const f32x2*)(plog + (size_t)tok * 128 + 2 * lane);
                q[u] = ssq[(size_t)tok * 16 + (lane & 15)]; }
#pragma unroll
            for (int u = 0; u < 4; ++u) {
                const int tok = 64 * k + 8 * wave + 4 * half + u;
                float a = v[u].x, b = v[u].y, s2 = q[u];
#pragma unroll
                for (int o = 4; o < 64; o <<= 1) { a += __shfl_xor(a, o); b += __shfl_xor(b, o); }
#pragma unroll
                for (int o = 1; o < 16; o <<= 1) s2 += __shfl_xor(s2, o);
                const float rs = __builtin_amdgcn_rsqf(s2 * (1.0f / DM) + RMS_EPS);
                float lg[8];
#pragma unroll
                for (int e = 0; e < 8; ++e) lg[e] = __shfl((e & 1) ? b : a, e >> 1) * rs;
                float v0 = -3.0e38f, v1 = -3.0e38f; int e0 = 0, e1 = 0;
#pragma unroll
                for (int e = 0; e < 8; ++e) { const float x = lg[e]; if (x > v0) { v1 = v0; e1 = e0; v0 = x; e0 = e; } else if (x > v1) { v1 = x; e1 = e; } }
                const float g0 = 1.0f / (1.0f + __expf(v1 - v0)), g1 = 1.0f - g0;
                if (lane == 0) { *(u32x2*)(toke + tok * 2) = (u32x2){(unsigned)e0, (unsigned)e1}; *(f32x2*)(tokg + tok * 2) = (f32x2){g0, g1}; }
#pragma unroll
                for (int e = 0; e < 8; ++e) hc[e] += (e == e0) + (e == e1);
            }
        }
        if (lane < 8) { int c = 0;
#pragma unroll
            for (int e = 0; e < 8; ++e) if (lane == e) c = hc[e];
            __hip_atomic_fetch_add((int*)(hist + lane), c, __ATOMIC_RELAXED, __HIP_MEMORY_SCOPE_WORKGROUP); }
        __syncthreads();
        if (tid < 8) ghist[k * 8 + tid] = hist[tid];
        __syncthreads();
    }
}

__device__ __forceinline__ void phase_slot(const Params& p, LAS unsigned char* lds) {
    const int tid = threadIdx.x, lane = tid & 63, wave = tid >> 6;
    int* cnt = (int*)(p.ws + OFF_CTL); const int* toke = (const int*)(p.ws + OFF_TOKE); int* tokp = (int*)(p.ws + OFF_TOKP); int* idx = (int*)(p.ws + OFF_IDX);
    const int* ghist = (const int*)(p.ws + OFF_CTL) + 16384;
    LAS int* hist = (LAS int*)lds;
    for (int k = blockIdx.x; k < T_TOK / 64; k += gridDim.x) {
        if (tid < 8) hist[tid] = 0;
        __syncthreads();
        { int c = 0;
#pragma unroll
            for (int i = 0; i < 4; ++i) { const int g = (tid >> 3) + 64 * i; if (g < k) c += ghist[g * 8 + (tid & 7)]; }
            if (c) __hip_atomic_fetch_add((int*)(hist + (tid & 7)), c, __ATOMIC_RELAXED, __HIP_MEMORY_SCOPE_WORKGROUP); }
        __syncthreads();
        if (wave == 0) {
            const int tok = 64 * k + lane; const u32x2 ee = *(const u32x2*)(toke + tok * 2);
            const float rs_tok = rstd_from_ssq((const float*)(p.ws + OFF_SSQB), tok); float* rse = (float*)(p.ws + OFF_RSE);
#pragma unroll
            for (int e = 0; e < 8; ++e) {
                const bool m0 = (int)ee.x == e, m1 = (int)ee.y == e, m = m0 || m1;
                const unsigned long long bal = __ballot(m);
                const int pre = __popcll(bal & ((1ull << lane) - 1ull));
                const int base = hist[e];
                if (m) { const int pos = base + pre; idx[(size_t)e * T_TOK + pos] = tok; tokp[tok * 2 + (m0 ? 0 : 1)] = pos; rse[(size_t)e * T_TOK + pos] = rs_tok; }
                if (k == T_TOK / 64 - 1 && lane == 0) cnt[e] = base + __popcll(bal);
            }
        }
        __syncthreads();
    }
}

__device__ __forceinline__ void phase_final(const Params& p, float* dst_override = nullptr) {
    const int tid = threadIdx.x, lane = tid & 63, wave = tid >> 6;
    const int gw = blockIdx.x * NWAVES + wave, NGW = gridDim.x * NWAVES;
    const int* cnt = (const int*)(p.ws + OFF_CTL); const int* toke = (const int*)(p.ws + OFF_TOKE); const int* tokp = (const int*)(p.ws + OFF_TOKP); const float* tokg = (const float*)(p.ws + OFF_TOKG);
    const float* fn = p.in[15];
    int base[8]; { int b = 0;
#pragma unroll
        for (int e = 0; e < 8; ++e) { base[e] = b; b += cnt[e]; } }
    f32x4 gfn[4];
#pragma unroll
    for (int j = 0; j < 4; ++j) gfn[j] = *(const f32x4*)(fn + 4 * lane + 256 * j);
    constexpr int NR = 2;
    for (int row0 = gw; row0 < T_TOK; row0 += NR * NGW) {
        int rowv[NR]; bool okv[NR]; int r0v[NR], r1v[NR]; float g0v[NR], g1v[NR];
#pragma unroll
        for (int u = 0; u < NR; ++u) { const int row = row0 + u * NGW; okv[u] = row < T_TOK; rowv[u] = okv[u] ? row : row0;
            const u32x2 ee = *(const u32x2*)(toke + rowv[u] * 2), pp = *(const u32x2*)(tokp + rowv[u] * 2); const f32x2 gg = *(const f32x2*)(tokg + rowv[u] * 2);
            int b0 = 0, b1 = 0;
#pragma unroll
            for (int e = 0; e < 8; ++e) { if (e == (int)ee.x) b0 = base[e]; if (e == (int)ee.y) b1 = base[e]; }
            r0v[u] = b0 + (int)pp.x; r1v[u] = b1 + (int)pp.y; g0v[u] = gg.x; g1v[u] = gg.y; }
        f32x4 v[NR][4]; u32x2 ya[NR][4], yc[NR][4], ya2[NR][4], yc2[NR][4];
#pragma unroll
        for (int u = 0; u < NR; ++u) {
            const u32x2* xr = (const u32x2*)((const bf16_t*)(p.ws + OFF_HB) + (size_t)rowv[u] * DM) + lane;
            const u32x2* y0 = (const u32x2*)EpiY::yrow(p.ws, 0, r0v[u]) + lane; const u32x2* y1 = (const u32x2*)EpiY::yrow(p.ws, 0, r1v[u]) + lane;
            const u32x2* y0b = (const u32x2*)EpiY::yrow(p.ws, 1, r0v[u]) + lane; const u32x2* y1b = (const u32x2*)EpiY::yrow(p.ws, 1, r1v[u]) + lane;
#pragma unroll
            for (int j = 0; j < 4; ++j) { const u32x2 hw = xr[64 * j]; v[u][j] = (f32x4){bflo(hw.x), bfhi(hw.x), bflo(hw.y), bfhi(hw.y)}; ya[u][j] = y0[64 * j]; yc[u][j] = y1[64 * j]; ya2[u][j] = y0b[64 * j]; yc2[u][j] = y1b[64 * j]; }
        }
#pragma unroll
        for (int u = 0; u < NR; ++u) {
            const float g0 = g0v[u], g1 = g1v[u]; float ss = 0.f;
#pragma unroll
            for (int j = 0; j < 4; ++j) { const u32x2 a = ya[u][j], c = yc[u][j], a2 = ya2[u][j], c2 = yc2[u][j];
                v[u][j].x += g0 * (bflo(a.x) + bflo(a2.x)) + g1 * (bflo(c.x) + bflo(c2.x)); v[u][j].y += g0 * (bfhi(a.x) + bfhi(a2.x)) + g1 * (bfhi(c.x) + bfhi(c2.x));
                v[u][j].z += g0 * (bflo(a.y) + bflo(a2.y)) + g1 * (bflo(c.y) + bflo(c2.y)); v[u][j].w += g0 * (bfhi(a.y) + bfhi(a2.y)) + g1 * (bfhi(c.y) + bfhi(c2.y));
                ss += (v[u][j].x * v[u][j].x + v[u][j].y * v[u][j].y) + (v[u][j].z * v[u][j].z + v[u][j].w * v[u][j].w); }
            ss = wave_sum(ss);
            const float rstd = 1.0f / sqrtf(ss * (1.0f / DM) + RMS_EPS);
            if (okv[u]) {
                f32x4* xw = (f32x4*)((dst_override ? dst_override : p.out) + (size_t)rowv[u] * DM) + lane;
#pragma unroll
                for (int j = 0; j < 4; ++j) xw[64 * j] = v[u][j] * rstd * gfn[j];
            }
        }
    }
}

#define XB_TMO      128
#define XB_XCNT(j)  (256  + 64 * (j))
#define XB_XSUB(j)  (1280 + 64 * (j))
#define XB_XGEN(j)  (2304 + 64 * (j))
#define XB_TOP      3328
#define XB_TOPGEN   3392
#define XCD_BAR_WORDS 3456
#define XB_SPIN_CAP (1u << 18)
__device__ __forceinline__ unsigned xb_ld(unsigned* p)              { return __hip_atomic_load(p, __ATOMIC_RELAXED, __HIP_MEMORY_SCOPE_AGENT); }
__device__ __forceinline__ unsigned xb_add(unsigned* p, unsigned v) { return __hip_atomic_fetch_add(p, v, __ATOMIC_RELAXED, __HIP_MEMORY_SCOPE_AGENT); }
__device__ __forceinline__ unsigned xb_xcc_id() { return (unsigned)__builtin_amdgcn_s_getreg((3 << 11) | 20) & 0xFu; }
#define XB_SPIN(cond, bar) do { unsigned _sp = 0; while (cond) { __builtin_amdgcn_s_sleep(1); \
    if ((++_sp & 255u) == 0u) { if (xb_ld(&(bar)[XB_TMO])) break; if (_sp > XB_SPIN_CAP) { atomicAdd(&(bar)[XB_TMO], 1u); break; } } } } while (0)
struct XcdBarrier { unsigned* bar; unsigned x; volatile LAS unsigned* st; };
__device__ __forceinline__ XcdBarrier xcd_barrier_post(unsigned* bar, volatile LAS unsigned* st) {
    XcdBarrier b; b.bar = bar; b.x = xb_xcc_id(); b.st = st;
    if (threadIdx.x == 0) (void)xb_add(&bar[XB_XCNT(b.x)], 1u);
    return b;
}
__device__ __forceinline__ void xcd_barrier_complete(unsigned* bar, unsigned x, unsigned& nloc, unsigned& nx) {
    const unsigned G = gridDim.x * gridDim.y * gridDim.z;
    unsigned sum, cnt, mine, sp = 0u;
    for (;;) {
        sum = 0u; cnt = 0u; mine = 0u;
#pragma unroll
        for (unsigned j = 0; j < 16; ++j) { const unsigned c = xb_ld(&bar[XB_XCNT(j)]); sum += c; cnt += (c > 0u) ? 1u : 0u; mine = (j == x) ? c : mine; }
        if (sum == G) break;
        __builtin_amdgcn_s_sleep(1);
        if ((++sp & 255u) == 0u) { if (xb_ld(&bar[XB_TMO])) break; if (sp > XB_SPIN_CAP) { atomicAdd(&bar[XB_TMO], 1u); break; } }
    }
    nloc = mine > 0u ? mine : 1u; nx = cnt > 0u ? cnt : 1u;
}
__device__ __forceinline__ void xcd_barrier(const XcdBarrier& b) {
    asm volatile("s_waitcnt vmcnt(0)" ::: "memory");
    __syncthreads();
    if (threadIdx.x == 0) {
        unsigned* bar = b.bar;
        __builtin_amdgcn_s_waitcnt(0);
        unsigned nloc = b.st[0], nx = b.st[1];
        if (nloc == 0u) { xcd_barrier_complete(bar, b.x, nloc, nx); b.st[0] = nloc; b.st[1] = nx; }
        const unsigned old = xb_add(&bar[XB_XSUB(b.x)], 1u);
        const unsigned gen = old / nloc;
        if (old + 1u == (gen + 1u) * nloc) {
            __builtin_amdgcn_fence(__ATOMIC_RELEASE, "agent");
            asm volatile("s_waitcnt vmcnt(0)" ::: "memory");
            const unsigned og = xb_add(&bar[XB_TOP], 1u);
            const unsigned tg = og / nx;
            if (og + 1u == (tg + 1u) * nx) xb_add(&bar[XB_TOPGEN], 1u);
            else XB_SPIN(xb_ld(&bar[XB_TOPGEN]) == tg, bar);
            __builtin_amdgcn_fence(__ATOMIC_ACQUIRE, "agent");
            xb_add(&bar[XB_XGEN(b.x)], 1u);
            asm volatile("s_waitcnt vmcnt(0)" ::: "memory");
        } else {
            XB_SPIN(xb_ld(&bar[XB_XGEN(b.x)]) == gen, bar);
            __builtin_amdgcn_fence(__ATOMIC_ACQUIRE, "agent");
            asm volatile("s_waitcnt vmcnt(0)" ::: "memory");
        }
    }
    __syncthreads();
}

__device__ __forceinline__ void phase_dbg_hash(const Params& p, const unsigned* buf, size_t nwords) {
    const int tid = threadIdx.x, lane = tid & 63, wave = tid >> 6;
    const int gw = blockIdx.x * NWAVES + wave, NGW = gridDim.x * NWAVES;
    const size_t cw = nwords / T_TOK;
    for (int row = gw; row < T_TOK; row += NGW) {
        const unsigned* b = buf + (size_t)row * cw;
        unsigned h = 0x9e3779b9u;
        for (size_t i = lane; i < cw; i += 64) { h = (h ^ __hip_atomic_load(b + i, __ATOMIC_RELAXED, __HIP_MEMORY_SCOPE_SYSTEM)) * 0x01000193u; h ^= h >> 15; }
#pragma unroll
        for (int o = 1; o < 64; o <<= 1) h = (h * 31u) ^ (unsigned)__shfl_xor((int)h, o);
        const float v = (float)(h & 0xffffu) * (1.0f / 65536.0f);
        f32x4* xr = (f32x4*)(p.out + (size_t)row * DM) + lane;
#pragma unroll
        for (int j = 0; j < 4; ++j) xr[64 * j] = (f32x4){v, v, v, v};
    }
}

enum { PH_PRO = 0, PH_IN0, PH_KM0, PH_AT0, PH_OUT0, PH_G1_0, PH_G2_0, PH_IN1, PH_KM1, PH_AT1, PH_OUT1, PH_ROUTER, PH_SLOT, PH_MG1, PH_MG2, PH_FINAL, NPHASES };

#if USE_FAST_GEMM
#define GEMM(A_, B_, K_, S_, E_) pg::gemm_fast<false>(lds, A_, B_, K_, K_, S_, E_)
#define GEMMH(A_, B_, K_, S_, E_) pg::gemm_fast<true>(lds, A_, B_, K_, K_, S_, E_)
#define GEMMK(A_, B_, K_, KL_, S_, E_) pg::gemm_fast<false>(lds, A_, B_, K_, KL_, S_, E_)
#else
#define GEMM(A_, B_, K_, S_, E_) gemm_simple(A_, B_, K_, K_, S_, E_)
#define GEMMH(A_, B_, K_, S_, E_) gemm_simple(A_, B_, K_, K_, S_, E_)
#define GEMMK(A_, B_, K_, KL_, S_, E_) gemm_simple(A_, B_, K_, KL_, S_, E_)
#endif
template <int PH>
__device__ __forceinline__ void run_phase(const Params& p, LAS unsigned char* lds) {
    unsigned char* ws = p.ws;
    const int G = gridDim.x, bid = blockIdx.x;
    if constexpr (PH == PH_PRO) { phase_prologue(p, lds); }
    else if constexpr (PH == PH_IN0 || PH == PH_IN1) {
        constexpr int l = PH == PH_IN0 ? 0 : 1;
        DenseSched S; S.init(T_TOK, NIN, G, bid, 1);
        DenseSched S2; S2.init(T_TOK, NIN, G, bid, 2);
        EpiInProj E{(const float*)(ws + OFF_SSQA), (const float*)(ws + OFF_ROPE), (const float*)(ws + OFF_ROPE) + SEQ * 32, (bf16_t*)(ws + OFF_Q), (bf16_t*)(ws + OFF_K), (bf16_t*)(ws + OFF_VT),
                    (float*)(ws + OFF_LOGF), p.in[3] + l * 4};
        GEMM((const bf16_t*)(ws + OFF_HB), (const bf16_t*)(ws + OFF_WIN) + (size_t)l * NIN * DM, DM, S, E);
        GEMMH((const bf16_t*)(ws + OFF_HB), (const bf16_t*)(ws + OFF_WIN) + (size_t)l * NIN * DM, DM, S2, E);
    }
    else if constexpr (PH == PH_KM0 || PH == PH_KM1) { phase_kmean(p, lds); phase_scan(p, lds);
        if constexpr (PH == PH_KM0) { __syncthreads(); conv_range(p, lds, I_IN, NITEMS_EARLY); }
        if constexpr (PH == PH_KM1) { __syncthreads(); conv_range(p, lds, NITEMS_EARLY, NITEMS_EARLY + MOE_KM1_ITEMS); }
    }
    else if constexpr (PH == PH_AT0 || PH == PH_AT1) {
#if USE_FAST_ATTN
        att::phase_attn(p, PH == PH_AT0 ? 0 : 1, lds);
#else
        phase_attn_naive(p, PH == PH_AT0 ? 0 : 1);
#endif
    }
    else if constexpr (PH == PH_OUT0 || PH == PH_OUT1) {
        constexpr int l = PH == PH_OUT0 ? 0 : 1;
        DenseSched S; S.init(T_TOK, DM, G, bid);
        EpiResid<(l == 1)> E{(bf16_t*)(ws + OFF_HB), (float*)(ws + OFF_SSQB), (const float*)(ws + OFF_WRT), (float*)(ws + OFF_PLOG)};
        GEMM((const bf16_t*)(ws + OFF_Y), (const bf16_t*)(ws + OFF_WOUT) + (size_t)l * DM * DM, DM, S, E);
        if constexpr (l == 1) {
            __syncthreads();
            conv_range(p, lds, NITEMS_EARLY + MOE_KM1_ITEMS, NITEMS_EARLY + NITEMS_MOE);
        }
    }
    else if constexpr (PH == PH_G1_0) {
        DenseSched S; S.init(T_TOK, 2 * FF, G, bid);
        EpiSwiGLU<false> E{(const float*)(ws + OFF_SSQB), (bf16_t*)(ws + OFF_DACT)};
        GEMM((const bf16_t*)(ws + OFF_HB), (const bf16_t*)(ws + OFF_DGU), DM, S, E);
    }
    else if constexpr (PH == PH_G2_0) {
        DenseSched S; S.init(T_TOK, DM, G, bid);
        EpiResid<false> E{(bf16_t*)(ws + OFF_HB), (float*)(ws + OFF_SSQA), nullptr, nullptr};
        GEMM((const bf16_t*)(ws + OFF_DACT), (const bf16_t*)(ws + OFF_DDN), FF, S, E);
    }
    else if constexpr (PH == PH_ROUTER) {
        phase_top2(p, lds);
    }
    else if constexpr (PH == PH_SLOT) { phase_slot(p, lds); }
    else if constexpr (PH == PH_MG1) {
        MoeSched S; S.init((const int*)(ws + OFF_CTL), (const int*)(ws + OFF_IDX), 28, 2 * FF, G, bid, true, 1, 0, 1);
        S.rse = (const float*)(ws + OFF_RSE);
        MoeSched S2; S2.init((const int*)(ws + OFF_CTL), (const int*)(ws + OFF_IDX), 28, 2 * FF, G, bid, true, 1, 0, 2);
        S2.rse = (const float*)(ws + OFF_RSE);
        EpiSwiGLU<true> E{nullptr, (bf16_t*)(ws + OFF_MACT)};
        GEMM((const bf16_t*)(ws + OFF_HB), (const bf16_t*)(ws + OFF_MGU), DM, S, E);
        GEMMH((const bf16_t*)(ws + OFF_HB), (const bf16_t*)(ws + OFF_MGU), DM, S2, E);
    }
    else if constexpr (PH == PH_MG2) {
        MoeSched S; S.init((const int*)(ws + OFF_CTL), (const int*)(ws + OFF_IDX), 4, DM, G, bid, false, 2, FF / 2);
        EpiY E{ws};
        GEMMK((const bf16_t*)(ws + OFF_MACT), (const bf16_t*)(ws + OFF_MDN), FF, FF / 2, S, E);
    }
    else if constexpr (PH == PH_FINAL) {
#ifdef DBG_FINAL_TWICE
        phase_final(p, (float*)(p.ws + OFF_Q));
#endif
        phase_final(p); }
}

template <int PH>
__global__ void __launch_bounds__(NTHREADS) mk_phase(Params p) {
    extern __shared__ __attribute__((aligned(16))) unsigned char lds_raw[];
    run_phase<PH>(p, (LAS unsigned char*)lds_raw);
}

#if !MK_MULTI
template <int PH>
__device__ __forceinline__ void run_from(const Params& p, LAS unsigned char* lds, cg::grid_group& grid, const XcdBarrier& xb) {
    if constexpr (PH < NPHASES) {
        if (PH >= p.ph_lo && PH < p.ph_hi) {
            if (PH > p.ph_lo) xcd_barrier(xb);
            run_phase<PH>(p, lds);
#ifdef DBG_REPEAT_MASK
            if ((DBG_REPEAT_MASK >> PH) & 1) { xcd_barrier(xb); run_phase<PH>(p, lds); }
#endif
        }
        run_from<PH + 1>(p, lds, grid, xb);
    }
}
__global__ void __launch_bounds__(NTHREADS) mk_fwd(Params p) {
    extern __shared__ __attribute__((aligned(16))) unsigned char lds_raw[];
    cg::grid_group grid = cg::this_grid();
    volatile LAS unsigned* xst = (volatile LAS unsigned*)((LAS unsigned char*)lds_raw + LDS_BYTES - 64);
    if (threadIdx.x < 2) xst[threadIdx.x] = 0u;
    __syncthreads();
    const XcdBarrier xb = xcd_barrier_post((unsigned*)(p.ws + OFF_CTL) + 1024, xst);
    if (p.ph_hi < 0) grid.sync();
    run_from<0>(p, (LAS unsigned char*)lds_raw, grid, xb);
#ifdef DBG_EXTRA_BARS
    for (int i = 0; i < DBG_EXTRA_BARS; ++i) xcd_barrier(xb);
#endif
#ifdef DBG_TWICE
    forget_pass(p, 0, 440 * MiB);
    grid.sync();
    {
        const unsigned* a = (const unsigned*)(p.ws + OFF_LOGF); const unsigned* b2 = (const unsigned*)(p.ws + OFF_LOGF + 440 * MiB);
        const int gt = blockIdx.x * NTHREADS + threadIdx.x;
        if (gt < 131072) { const float f = (a[gt] != b2[gt]) ? 1.0f : 0.0f; for (int k = 0; k < 128; ++k) p.out[(size_t)gt * 128 + k] = f; }
    }
#elif defined(DBG_HASH_SEL)
    xcd_barrier(xb);
    {
        constexpr int sel = DBG_HASH_SEL;
        const unsigned* b; size_t nw;
        if (sel == 0) { b = (const unsigned*)p.out; nw = (size_t)T_TOK * 1024; }
        else if (sel == 20) { b = (const unsigned*)p.in[0]; nw = (size_t)T_TOK * 1024; }
        else if (sel == 21) { b = (const unsigned*)p.in[2]; nw = (size_t)T_TOK * 288; }
        else if (sel == 1) { b = (const unsigned*)(p.ws + OFF_HB); nw = (size_t)T_TOK * 512; }
        else if (sel == 2) { b = (const unsigned*)(p.ws + OFF_Q); nw = (size_t)T_TOK * 512; }
        else if (sel == 3) { b = (const unsigned*)(p.ws + OFF_K); nw = (size_t)T_TOK * 640; }
        else if (sel == 4) { b = (const unsigned*)(p.ws + OFF_VT); nw = (size_t)T_TOK * 320; }
        else if (sel == 5) { b = (const unsigned*)(p.ws + OFF_Y); nw = (size_t)T_TOK * 512; }
        else if (sel == 6) { b = (const unsigned*)(p.ws + OFF_SSQA); nw = (size_t)T_TOK * 16; }
        else if (sel == 7) { b = (const unsigned*)(p.ws + OFF_SSQB); nw = (size_t)T_TOK * 16; }
        else if (sel == 8) { b = (const unsigned*)(p.ws + OFF_WIN); nw = (size_t)T_TOK * 544; }
        else if (sel == 9) { b = (const unsigned*)(p.ws + OFF_MGU); nw = (size_t)T_TOK * 1792; }
        else if (sel == 10) { b = (const unsigned*)(p.ws + OFF_MDN); nw = (size_t)T_TOK * 896; }
        else if (sel == 11) { b = (const unsigned*)(p.ws + OFF_DACT); nw = (size_t)T_TOK * 1792; }
        else if (sel == 12) { b = (const unsigned*)(p.ws + OFF_ROPE); nw = (size_t)T_TOK * 8; }
        else if (sel == 13) { b = (const unsigned*)(p.ws + OFF_LOGF); nw = (size_t)T_TOK * 4; }
        else { b = (const unsigned*)(p.ws + OFF_KMEAN); nw = (size_t)T_TOK * 1; }
        phase_dbg_hash(p, b, nw);
    }
#endif
}
#endif

template <int PH> static void launch_phase(const Params& p, int grid, hipStream_t stream) {
    static bool attr_done = false;
    if (!attr_done) { (void)hipFuncSetAttribute((const void*)mk_phase<PH>, hipFuncAttributeMaxDynamicSharedMemorySize, LDS_BYTES); attr_done = true; }
    hipLaunchKernelGGL(mk_phase<PH>, dim3(grid), dim3(NTHREADS), LDS_BYTES, stream, p);
}
#ifndef DBG_NPH
#define DBG_NPH NPHASES
#endif
template <int PH> static void launch_all(const Params& p, int grid, hipStream_t stream) {
    if constexpr (PH < DBG_NPH) { launch_phase<PH>(p, grid, stream); launch_all<PH + 1>(p, grid, stream); }
}

extern "C" void kernel_launch(void* const* d_in, const int* in_sizes, int n_in, void* d_out, int out_size, void* d_ws, size_t ws_size, hipStream_t stream) {
    static int grid = 0;
    if (grid == 0) {
        int dev = 0, cus = 0;
        (void)hipGetDevice(&dev);
        (void)hipDeviceGetAttribute(&cus, hipDeviceAttributeMultiprocessorCount, dev);
#if !MK_MULTI
        int per_cu = 0;
        (void)hipFuncSetAttribute((const void*)mk_fwd, hipFuncAttributeMaxDynamicSharedMemorySize, LDS_BYTES);
        (void)hipOccupancyMaxActiveBlocksPerMultiprocessor(&per_cu, (const void*)mk_fwd, NTHREADS, LDS_BYTES);
        if (per_cu < 1) fprintf(stderr, "kernel_launch: occupancy query says %d blocks/CU\n", per_cu);
#endif
        grid = cus;
        if (n_in != 16 || ws_size < WS_NEED) fprintf(stderr, "kernel_launch: unexpected n_in %d or ws_size %zu (< %zu)\n", n_in, ws_size, (size_t)WS_NEED);
    }
    if (ws_size < WS_NEED || n_in != 16) return;
    (void)hipMemsetAsync((char*)d_ws + OFF_CTL, 0, CTL_BYTES, stream);
    Params p{};
    for (int i = 0; i < 16; ++i) p.in[i] = (const float*)d_in[i];
    p.out = (float*)d_out; p.ws = (unsigned char*)d_ws;
#if MK_MULTI
    p.ph_lo = 0; p.ph_hi = NPHASES;
    launch_all<0>(p, grid, stream);
#else
    p.ph_lo = 0; p.ph_hi = DBG_NPH;
    void* args[] = {&p};
    hipError_t e = hipLaunchCooperativeKernel((const void*)mk_fwd, dim3(grid), dim3(NTHREADS), args, LDS_BYTES, stream);
    if (e != hipSuccess) fprintf(stderr, "cooperative launch failed: %s (grid %d)\n", hipGetErrorString(e), grid);
#endif
}
#ifdef ATT_PROBE
template <int KIND> __global__ void __launch_bounds__(NTHREADS) att_probe(Params p) {
    extern __shared__ __attribute__((aligned(16))) unsigned char lds_raw[];
    att::attn_unit<KIND>(p, 0, (LAS unsigned char*)lds_raw, blockIdx.x & 7, blockIdx.x >> 3);
}
template __global__ void att_probe<0>(Params);
template __global__ void att_probe<1>(Params);
template __global__ void att_probe<2>(Params);
#endif
```
